# Optimizing an MI355X kernel written in HIP

```python
import jax, jax.numpy as jnp
from jax import lax
import numpy as np

D_MODEL = 4096
BATCH = 4
SEQ = 2048
DEPTH = 2

N_MIXERS = 2
EXPAND = 2
D_INNER = EXPAND * D_MODEL
CHUNK = 128
A_HEADS = 16
A_HEAD_DIM = D_INNER // A_HEADS
POOL_WINDOWS = (2, 4, 8, 16)
B_GROUPS = len(POOL_WINDOWS)
B_GROUP_DIM = D_INNER // B_GROUPS
N_A_LAYERS = (DEPTH + 1) // 2
N_B_LAYERS = DEPTH // 2
EPS = 1e-6

kernel_name = "hybrid_gmlp_pool_sandwich_trunk"


def rms_norm(x, g):
    x32 = x.astype(jnp.float32)
    y = x32 * lax.rsqrt(jnp.mean(x32 * x32, axis=-1, keepdims=True) + EPS)
    return (y * g.astype(jnp.float32)).astype(x.dtype)


def layer_norm(x, g, b):
    x32 = x.astype(jnp.float32)
    mu = jnp.mean(x32, axis=-1, keepdims=True)
    xc = x32 - mu
    y = xc * lax.rsqrt(jnp.mean(xc * xc, axis=-1, keepdims=True) + EPS)
    return (y * g.astype(jnp.float32) + b.astype(jnp.float32)).astype(x.dtype)


def mixer_a(h, w_in, ln_g, ln_b, w_s, b_s, w_out):
    bsz, s, _ = h.shape
    proj = h @ w_in
    u, v, z = jnp.split(proj, 3, axis=-1)
    u = jax.nn.gelu(u, approximate=False)
    v = layer_norm(jax.nn.gelu(v, approximate=False), ln_g, ln_b)
    v = v.reshape(bsz, s // CHUNK, CHUNK, A_HEADS, A_HEAD_DIM)
    w_causal = jnp.tril(w_s)
    sv = jnp.einsum('hts,bnshd->bnthd', w_causal, v) + b_s.T[:, :, None]
    sgu = u * sv.reshape(bsz, s, D_INNER)
    y = sgu * jax.nn.silu(z)
    return y @ w_out


def mixer_b(h, w_in, w_grp, b_grp, scale, w_out):
    bsz, s, _ = h.shape
    proj = h @ w_in
    p, z = jnp.split(proj, 2, axis=-1)
    p = p.reshape(bsz, s, B_GROUPS, B_GROUP_DIM)
    p32 = p.astype(jnp.float32)
    csum = jnp.cumsum(p32, axis=1)
    pos = jnp.arange(1, s + 1, dtype=jnp.float32)
    means = []
    for k, w in enumerate(POOL_WINDOWS):
        ck = csum[:, :, k]
        lagged = jnp.pad(ck, ((0, 0), (w, 0), (0, 0)))[:, :s]
        count = jnp.minimum(pos, float(w))[:, None]
        means.append((ck - lagged) / count)
    pooled = (jnp.stack(means, axis=2) - p32).astype(p.dtype)
    mixed = jnp.einsum('bsgc,gcd->bsgd', pooled, w_grp) + b_grp
    mixed = mixed.reshape(bsz, s, D_INNER) * scale
    y = mixed * jax.nn.silu(z)
    return y @ w_out


def setup_inputs(seed: int = 0) -> dict:
    key = jax.random.key(seed)
    ks = jax.random.split(key, 16)
    f32 = jnp.float32
    nrm = lambda k, shape, sc: jax.random.normal(k, shape, f32) * sc
    x = nrm(ks[0], (BATCH, SEQ, D_MODEL), 1.0)
    pre_norm = 1.0 + nrm(ks[1], (DEPTH, D_MODEL), 0.02)
    post_norm = 1.0 + nrm(ks[2], (DEPTH, D_MODEL), 0.02)
    a_w_in = nrm(ks[3], (N_A_LAYERS, D_MODEL, 3 * D_INNER), D_MODEL ** -0.5)
    a_ln_g = 1.0 + nrm(ks[4], (N_A_LAYERS, D_INNER), 0.02)
    a_ln_b = nrm(ks[5], (N_A_LAYERS, D_INNER), 0.02)
    a_w_s = nrm(ks[6], (N_A_LAYERS, A_HEADS, CHUNK, CHUNK), CHUNK ** -0.5)
    a_b_s = 1.0 + nrm(ks[7], (N_A_LAYERS, A_HEADS, CHUNK), 0.01)
    a_w_out = nrm(ks[8], (N_A_LAYERS, D_INNER, D_MODEL), D_INNER ** -0.5)
    b_w_in = nrm(ks[9], (N_B_LAYERS, D_MODEL, 2 * D_INNER), D_MODEL ** -0.5)
    b_w_grp = nrm(ks[10], (N_B_LAYERS, B_GROUPS, B_GROUP_DIM, B_GROUP_DIM), B_GROUP_DIM ** -0.5)
    b_b_grp = nrm(ks[11], (N_B_LAYERS, B_GROUPS, B_GROUP_DIM), 0.02)
    b_scale = 1.0 + nrm(ks[12], (N_B_LAYERS, D_INNER), 0.02)
    b_w_out = nrm(ks[13], (N_B_LAYERS, D_INNER, D_MODEL), D_INNER ** -0.5)
    return {"x": x, "pre_norm": pre_norm, "post_norm": post_norm,
            "a_w_in": a_w_in, "a_ln_g": a_ln_g, "a_ln_b": a_ln_b,
            "a_w_s": a_w_s, "a_b_s": a_b_s, "a_w_out": a_w_out,
            "b_w_in": b_w_in, "b_w_grp": b_w_grp, "b_b_grp": b_b_grp,
            "b_scale": b_scale, "b_w_out": b_w_out}


def reference(x, pre_norm, post_norm, a_w_in, a_ln_g, a_ln_b, a_w_s, a_b_s, a_w_out,
              b_w_in, b_w_grp, b_b_grp, b_scale, b_w_out):
    for i in range(DEPTH):
        h = rms_norm(x, pre_norm[i])
        j = i // N_MIXERS
        if i % N_MIXERS == 0:
            m = mixer_a(h, a_w_in[j], a_ln_g[j], a_ln_b[j], a_w_s[j], a_b_s[j], a_w_out[j])
        else:
            m = mixer_b(h, b_w_in[j], b_w_grp[j], b_b_grp[j], b_scale[j], b_w_out[j])
        x = x + rms_norm(m, post_norm[i])
    return x
```

```cpp
#include <hip/hip_runtime.h>
#include <cstdio>
#include <cstdint>

#ifndef NAIVE_MASK
#define NAIVE_MASK 0
#endif

namespace pg8 {
#define PG8_LAS __attribute__((address_space(3)))
typedef unsigned short bf16_t;
typedef short bf16x8 __attribute__((ext_vector_type(8)));
typedef float f32x4 __attribute__((ext_vector_type(4)));
typedef unsigned u32x4 __attribute__((ext_vector_type(4)));
constexpr int BM = 256, BK = 64, HALF = 128, HTB = HALF * BK * 2  , STAGE_BYTES = 8 * HTB, NXCD = 8, WGM = 8;

__host__ __device__ __forceinline__ int lds_byte(int r, int c) { const int st = (r >> 4) * 2 + (c >> 5), rr = r & 15, cc = c & 31, ob = rr * 64 + cc * 2; return st * 1024 + (ob ^ (((ob >> 9) & 1) << 5)); }
__host__ __device__ __forceinline__ void stage_rc(int b, int& R, int& C) { const int st = b / 1024, sb = b % 1024, swz = sb ^ (((sb >> 9) & 1) << 5); R = (st >> 1) * 16 + swz / 64; C = (st & 1) * 32 + (swz % 64) / 2; }
__host__ __device__ __forceinline__ int perm32(int rho) { const int n = rho >> 4, i = rho & 15; return 8 * (i >> 2) + 4 * n + (i & 3); }

struct Unit { int pm, pn; };
struct Gemm { const bf16_t* A; const bf16_t* Bt; int lda, ldb, K; int agrp_tiles, agrp_cols;
    __device__ __forceinline__ size_t acol(int pn) const { return agrp_tiles ? (size_t)(pn / agrp_tiles) * (size_t)agrp_cols * 2u : (size_t)0; } };

struct StaticOrder {
    int nM, nN, nwg, G, c;
    __host__ __device__ void init(int M, int N, int G_, int c_) { nM = M / BM; nN = N / BM; nwg = nM * nN; G = G_; c = c_; }
    __host__ __device__ bool next(int i, Unit& u) const {
        const long L = (long)i * G + c; if (L >= nwg) return false;
        int wgid = (int)L; { const int q = nwg / NXCD, r = nwg % NXCD, xcd = wgid % NXCD, off = wgid / NXCD; wgid = (xcd < r ? xcd * (q + 1) : r * (q + 1) + (xcd - r) * q) + off; }
        const int nig = WGM * nN, gid = wgid / nig, fm = gid * WGM, gsz = (nM - fm) < WGM ? (nM - fm) : WGM;
        u.pm = fm + ((wgid % nig) % gsz); u.pn = (wgid % nig) / gsz; return true;
    }
    __device__ __forceinline__ void a_ready(const Unit&) const {}
    __device__ __forceinline__ void done(const Unit&) const {}
};

__device__ __forceinline__ unsigned cvt_pk_bf16(float lo, float hi) { unsigned r; asm volatile("v_cvt_pk_bf16_f32 %0, %1, %2" : "=v"(r) : "v"(lo), "v"(hi)); return r; }
typedef float f32x2 __attribute__((ext_vector_type(2)));
__device__ __forceinline__ f32x2 gelu_pk(f32x2 v) {
    const f32x2 av = __builtin_elementwise_abs(v), d = av * 0.2316418882f + 1.0f;
    f32x2 t; t.x = __builtin_amdgcn_rcpf(d.x); t.y = __builtin_amdgcn_rcpf(d.y);
    f32x2 q = t * 0.5307027145f + (-0.7265760135f); q = q * t + 0.7107068705f; q = q * t + (-0.142248368f); q = q * t + 0.127414796f; q = q * t;
    const f32x2 s = (v * v) * (-0.72134752044f);
    f32x2 e; e.x = __builtin_amdgcn_exp2f(s.x); e.y = __builtin_amdgcn_exp2f(s.y);
    const f32x2 m = v * (q * e), r = v - m;
    f32x2 o; o.x = v.x < 0.f ? m.x : r.x; o.y = v.y < 0.f ? m.y : r.y; return o;
}

__device__ __forceinline__ float silu1(float z) { return z * __builtin_amdgcn_rcpf(1.0f + __builtin_amdgcn_exp2f(z * -1.4426950408889634f)); }
__device__ __forceinline__ f32x4 gelu4(f32x4 v) { const f32x2 a = gelu_pk((f32x2){v[0], v[1]}), b = gelu_pk((f32x2){v[2], v[3]}); return (f32x4){a.x, a.y, b.x, b.y}; }
__device__ __forceinline__ f32x4 silu4(f32x4 v) { return (f32x4){silu1(v[0]), silu1(v[1]), silu1(v[2]), silu1(v[3])}; }
__device__ __forceinline__ u32x4 pack8(f32x4 a, f32x4 b) { u32x4 w; w.x = cvt_pk_bf16(a[0], a[1]); w.y = cvt_pk_bf16(a[2], a[3]); w.z = cvt_pk_bf16(b[0], b[1]); w.w = cvt_pk_bf16(b[2], b[3]); return w; }
__device__ __forceinline__ f32x4 unpk_lo(u32x4 w) { return (f32x4){__uint_as_float(w.x << 16), __uint_as_float(w.x & 0xffff0000u), __uint_as_float(w.y << 16), __uint_as_float(w.y & 0xffff0000u)}; }
__device__ __forceinline__ f32x4 unpk_hi(u32x4 w) { return (f32x4){__uint_as_float(w.z << 16), __uint_as_float(w.z & 0xffff0000u), __uint_as_float(w.w << 16), __uint_as_float(w.w & 0xffff0000u)}; }

struct EpiPlain {
    static constexpr bool PERM = true, AFTER_DRAIN = false;
    bf16_t* O; int ldc;
    __device__ __forceinline__ void operator()(const f32x4 (&acc)[2][2][4][2], const Unit& u, int wr, int wc, int fr, int fq) const {
        const int row0 = u.pm * BM + wr * 64 + fr, col0 = u.pn * BM + wc * 32 + 8 * fq;
#pragma unroll
        for (int ai = 0; ai < 2; ++ai)
#pragma unroll
            for (int m = 0; m < 4; ++m) { bf16_t* rowp = O + (size_t)(row0 + ai * HALF + m * 16) * ldc + col0;
#pragma unroll
                for (int bj = 0; bj < 2; ++bj) *(u32x4*)(rowp + bj * HALF) = pack8(acc[ai][bj][m][0], acc[ai][bj][m][1]); }
    }
};
struct EpiUZ {
    static constexpr bool PERM = true, AFTER_DRAIN = false;
    bf16_t* O; int ldc;
    __device__ __forceinline__ void operator()(const f32x4 (&acc)[2][2][4][2], const Unit& u, int wr, int wc, int fr, int fq) const {
        const int row0 = u.pm * BM + wr * 64 + fr, ch0 = u.pn * HALF + wc * 32 + 8 * fq;
#pragma unroll
        for (int ai = 0; ai < 2; ++ai)
#pragma unroll
            for (int m = 0; m < 4; ++m) { bf16_t* rowp = O + (size_t)(row0 + ai * HALF + m * 16) * ldc + ch0;
                const f32x4 g0 = gelu4(acc[ai][0][m][0]), g1 = gelu4(acc[ai][0][m][1]), s0 = silu4(acc[ai][1][m][0]), s1 = silu4(acc[ai][1][m][1]);
                *(u32x4*)rowp = pack8(g0 * s0, g1 * s1); }
    }
};
struct EpiGvT {
    static constexpr bool PERM = true, AFTER_DRAIN = false;
    bf16_t* O; int ldc; float* ST; int ntok;
    __device__ __forceinline__ void operator()(const f32x4 (&acc)[2][2][4][2], const Unit& u, int wr, int wc, int fr, int fq) const {
        const int ch0 = u.pm * BM + wr * 64 + fr, tok0 = u.pn * BM + wc * 32 + 8 * fq;
        f32x4 s1[2][2], s2[2][2];
#pragma unroll
        for (int bj = 0; bj < 2; ++bj)
#pragma unroll
            for (int n = 0; n < 2; ++n) { s1[bj][n] = (f32x4){0.f, 0.f, 0.f, 0.f}; s2[bj][n] = (f32x4){0.f, 0.f, 0.f, 0.f}; }
#pragma unroll
        for (int ai = 0; ai < 2; ++ai)
#pragma unroll
            for (int m = 0; m < 4; ++m) { bf16_t* rowp = O + (size_t)(ch0 + ai * HALF + m * 16) * ldc + tok0;
#pragma unroll
                for (int bj = 0; bj < 2; ++bj) { const f32x4 v0 = gelu4(acc[ai][bj][m][0]), v1 = gelu4(acc[ai][bj][m][1]);
                    s1[bj][0] += v0; s2[bj][0] += v0 * v0; s1[bj][1] += v1; s2[bj][1] += v1 * v1;
                    *(u32x4*)(rowp + bj * HALF) = pack8(v0, v1); } }
#pragma unroll
        for (int bj = 0; bj < 2; ++bj)
#pragma unroll
            for (int n = 0; n < 2; ++n)
#pragma unroll
                for (int e = 0; e < 4; ++e) { float a = s1[bj][n][e], b = s2[bj][n][e];
#pragma unroll
                    for (int o = 1; o < 16; o <<= 1) { a += __shfl_xor(a, o); b += __shfl_xor(b, o); }
                    s1[bj][n][e] = a; s2[bj][n][e] = b; }
        if (fr == 0) { float* st = ST + ((size_t)(u.pm * 2 + wr) * ntok + tok0) * 2;
#pragma unroll
            for (int bj = 0; bj < 2; ++bj)
#pragma unroll
                for (int n = 0; n < 2; ++n) { float* q = st + (bj * HALF + 4 * n) * 2;
                    *(f32x4*)q = (f32x4){s1[bj][n][0], s2[bj][n][0], s1[bj][n][1], s2[bj][n][1]};
                    *(f32x4*)(q + 4) = (f32x4){s1[bj][n][2], s2[bj][n][2], s1[bj][n][3], s2[bj][n][3]}; } }
    }
};
struct EpiPZ {
    static constexpr bool PERM = true, AFTER_DRAIN = false;
    bf16_t* P; bf16_t* SZ; int ldc; int nP;
    __device__ __forceinline__ void operator()(const f32x4 (&acc)[2][2][4][2], const Unit& u, int wr, int wc, int fr, int fq) const {
        const bool isz = u.pn >= nP; bf16_t* base = isz ? SZ : P;
        const int row0 = u.pm * BM + wr * 64 + fr, col0 = (isz ? u.pn - nP : u.pn) * BM + wc * 32 + 8 * fq;
#pragma unroll
        for (int ai = 0; ai < 2; ++ai)
#pragma unroll
            for (int m = 0; m < 4; ++m) { bf16_t* rowp = base + (size_t)(row0 + ai * HALF + m * 16) * ldc + col0;
#pragma unroll
                for (int bj = 0; bj < 2; ++bj) { f32x4 v0 = acc[ai][bj][m][0], v1 = acc[ai][bj][m][1];
                    if (isz) { v0 = silu4(v0); v1 = silu4(v1); }
                    *(u32x4*)(rowp + bj * HALF) = pack8(v0, v1); } }
    }
};
struct EpiMix {
    static constexpr bool PERM = true, AFTER_DRAIN = false;
    const bf16_t* SZ; bf16_t* Y; int ldc; const float* bgrp; const float* scale;
    __device__ __forceinline__ void operator()(const f32x4 (&acc)[2][2][4][2], const Unit& u, int wr, int wc, int fr, int fq) const {
        const int row0 = u.pm * BM + wr * 64 + fr, ch0 = u.pn * BM + wc * 32 + 8 * fq;
        f32x4 sc[2][2], bs[2][2];
#pragma unroll
        for (int bj = 0; bj < 2; ++bj)
#pragma unroll
            for (int n = 0; n < 2; ++n) { sc[bj][n] = *(const f32x4*)(scale + ch0 + bj * HALF + 4 * n); bs[bj][n] = *(const f32x4*)(bgrp + ch0 + bj * HALF + 4 * n) * sc[bj][n]; }
#pragma unroll
        for (int ai = 0; ai < 2; ++ai)
#pragma unroll
            for (int m = 0; m < 4; ++m) { const size_t off = (size_t)(row0 + ai * HALF + m * 16) * ldc + ch0;
#pragma unroll
                for (int bj = 0; bj < 2; ++bj) { const u32x4 z = *(const u32x4*)(SZ + off + bj * HALF);
                    const f32x4 v0 = (acc[ai][bj][m][0] * sc[bj][0] + bs[bj][0]) * unpk_lo(z), v1 = (acc[ai][bj][m][1] * sc[bj][1] + bs[bj][1]) * unpk_hi(z);
                    *(u32x4*)(Y + off + bj * HALF) = pack8(v0, v1); } }
    }
};

template <class Epi, class Sched, bool ALIGN_EPI = false, bool SP2 = false>
__device__ __forceinline__ void gemm_phase(PG8_LAS unsigned char* lds, const Gemm g, const Sched& S, const Epi& E) {
    const int tid = threadIdx.x, wid = __builtin_amdgcn_readfirstlane(tid >> 6), lane = tid & 63, wr = wid >> 2, wc = wid & 3, fr = lane & 15, fq = lane >> 4;
    const int K = g.K, nt = K / BK;
    unsigned voffA[2], voffB[2];
#pragma unroll
    for (int i = 0; i < 2; ++i) { int R, C; stage_rc(tid * 16 + i * 8192, R, C); const int Rb = Epi::PERM ? ((R & ~31) + perm32(R & 31)) : R;
        voffA[i] = (unsigned)(R * g.lda + C) * 2u; voffB[i] = (unsigned)(Rb * g.ldb + C) * 2u; }
    const size_t kstep = (size_t)(BK * 2);
    const size_t hstepA = (size_t)HALF * g.lda * 2, hstepB = (size_t)HALF * g.ldb * 2;
    const size_t tstepA = 2 * hstepA, tstepB = 2 * hstepB;
    const unsigned ldsw = (unsigned)wid * 1024u;
    const int aoff = lds_byte(wr * 64 + fr, fq * 8), boff = lds_byte(wc * 32 + fr, fq * 8);
#define PG8_SA(b, h) (((b) * 2 + (h)) * HTB)
#define PG8_SB(b, h) ((4 + (b) * 2 + (h)) * HTB)
#define PG8_STAGE(bufoff, gbase, voff) do { _Pragma("unroll") for (int _i = 0; _i < 2; ++_i) \
        __builtin_amdgcn_global_load_lds((const unsigned*)((const char*)(gbase) + (voff)[_i]), (PG8_LAS unsigned*)(lds + (bufoff) + ldsw + _i * 8192), 16, 0, 0); } while (0)
#define PG8_LDA(dst, b, h) do { _Pragma("unroll") for (int m = 0; m < 4; ++m) _Pragma("unroll") for (int k = 0; k < 2; ++k) dst[m][k] = *(const PG8_LAS bf16x8*)(lds + PG8_SA(b, h) + aoff + m * 2048 + k * 1024); } while (0)
#define PG8_LDB(dst, b, h) do { _Pragma("unroll") for (int n = 0; n < 2; ++n) _Pragma("unroll") for (int k = 0; k < 2; ++k) dst[n][k] = *(const PG8_LAS bf16x8*)(lds + PG8_SB(b, h) + boff + n * 2048 + k * 1024); } while (0)
#define PG8_MMA(ai, bj, At, Bt) do { __builtin_amdgcn_s_setprio(1); _Pragma("unroll") for (int m = 0; m < 4; ++m) _Pragma("unroll") for (int n = 0; n < 2; ++n) _Pragma("unroll") for (int k = 0; k < 2; ++k) \
        acc[ai][bj][m][n] = __builtin_amdgcn_mfma_f32_16x16x32_bf16(Bt[n][k], At[m][k], acc[ai][bj][m][n], 0, 0, 0); __builtin_amdgcn_s_setprio(0); } while (0)
#define PG8_WAIT_V(n) asm volatile("s_waitcnt vmcnt(" #n ")" ::: "memory")
#define PG8_WAIT_L(n) asm volatile("s_waitcnt lgkmcnt(" #n ")" ::: "memory")
#define PG8_BAR __builtin_amdgcn_s_barrier()
#define PG8_SCHED __builtin_amdgcn_sched_barrier(0)
    Unit cur, nxt; int ui = 0;
    if (!S.next(0, cur)) return;
    f32x4 acc[2][2][4][2];
#pragma unroll
    for (int a = 0; a < 2; ++a)
#pragma unroll
        for (int b = 0; b < 2; ++b)
#pragma unroll
            for (int m = 0; m < 4; ++m)
#pragma unroll
                for (int n = 0; n < 2; ++n) acc[a][b][m][n] = (f32x4){0.f, 0.f, 0.f, 0.f};
    bf16x8 At[4][2], B0[2][2], B1[2][2];
    const char* cA = (const char*)g.A + (size_t)cur.pm * tstepA + g.acol(cur.pn); const char* cB = (const char*)g.Bt + (size_t)cur.pn * tstepB;
    S.a_ready(cur);
    if constexpr (SP2) {
        PG8_STAGE(PG8_SB(0, 0), cB, voffB); PG8_STAGE(PG8_SB(0, 1), cB + hstepB, voffB); PG8_STAGE(PG8_SA(0, 0), cA, voffA); PG8_STAGE(PG8_SA(0, 1), cA + hstepA, voffA);
        if (wr == 1) PG8_BAR;
        PG8_WAIT_V(2); PG8_BAR;
        PG8_STAGE(PG8_SB(1, 0), cB + kstep, voffB); PG8_STAGE(PG8_SA(1, 0), cA + kstep, voffA); PG8_STAGE(PG8_SB(1, 1), cB + hstepB + kstep, voffB);
        PG8_WAIT_V(6); PG8_BAR;
    } else {
        PG8_STAGE(PG8_SB(0, 0), cB, voffB); PG8_STAGE(PG8_SA(0, 0), cA, voffA); PG8_STAGE(PG8_SB(0, 1), cB + hstepB, voffB); PG8_STAGE(PG8_SA(0, 1), cA + hstepA, voffA);
        if (wr == 1) PG8_BAR;
        PG8_WAIT_V(4); PG8_BAR;
        PG8_STAGE(PG8_SB(1, 0), cB + kstep, voffB); PG8_STAGE(PG8_SA(1, 0), cA + kstep, voffA); PG8_STAGE(PG8_SB(1, 1), cB + hstepB + kstep, voffB);
        PG8_WAIT_V(6); PG8_BAR;
    }
    for (;;) {
        const bool has_next = S.next(ui + 1, nxt);
        const char* nA = has_next ? (const char*)g.A + (size_t)nxt.pm * tstepA + g.acol(nxt.pn) : cA; const char* nB = has_next ? (const char*)g.Bt + (size_t)nxt.pn * tstepB : cB;
        for (int t = 0; t < nt; t += 2) {
            const bool last = (t == nt - 2);
            const char* a1 = cA + (size_t)(t + 1) * kstep;
            const char* a2 = last ? nA : cA + (size_t)(t + 2) * kstep; const char* b2 = last ? nB : cB + (size_t)(t + 2) * kstep;
            const char* a3 = a2 + kstep; const char* b3 = b2 + kstep;
            if (last && has_next) S.a_ready(nxt);
            if constexpr (SP2) {
            PG8_LDB(B0, 0, 0); PG8_LDB(B1, 0, 1); PG8_SCHED; PG8_LDA(At, 0, 0); PG8_STAGE(PG8_SA(1, 1), a1 + hstepA, voffA);
            PG8_WAIT_V(8); PG8_WAIT_L(0); PG8_BAR; PG8_MMA(0, 0, At, B0); PG8_MMA(0, 1, At, B1); PG8_BAR; PG8_SCHED;
            PG8_LDA(At, 0, 1); PG8_STAGE(PG8_SB(0, 0), b2, voffB); PG8_STAGE(PG8_SB(0, 1), b2 + hstepB, voffB); PG8_STAGE(PG8_SA(0, 0), a2, voffA);
            PG8_WAIT_V(8); PG8_WAIT_L(0); PG8_BAR; PG8_MMA(1, 0, At, B0); PG8_MMA(1, 1, At, B1); PG8_BAR; PG8_SCHED;
            PG8_LDB(B0, 1, 0); PG8_LDB(B1, 1, 1); PG8_SCHED; PG8_LDA(At, 1, 0); PG8_STAGE(PG8_SA(0, 1), a2 + hstepA, voffA);
            PG8_WAIT_V(8); PG8_WAIT_L(0); PG8_BAR; PG8_MMA(0, 0, At, B0); PG8_MMA(0, 1, At, B1); PG8_BAR; PG8_SCHED;
            PG8_LDA(At, 1, 1); PG8_STAGE(PG8_SB(1, 0), b3, voffB); PG8_STAGE(PG8_SB(1, 1), b3 + hstepB, voffB); PG8_STAGE(PG8_SA(1, 0), a3, voffA);
            PG8_WAIT_V(8); PG8_WAIT_L(0); PG8_BAR; PG8_MMA(1, 0, At, B0); PG8_MMA(1, 1, At, B1); PG8_BAR; PG8_SCHED;
            } else {
            PG8_LDB(B0, 0, 0); PG8_SCHED; PG8_LDA(At, 0, 0); PG8_STAGE(PG8_SA(1, 1), a1 + hstepA, voffA);
            PG8_WAIT_L(8); PG8_BAR; PG8_WAIT_L(0); PG8_MMA(0, 0, At, B0); PG8_BAR; PG8_SCHED;
            PG8_LDB(B1, 0, 1); PG8_STAGE(PG8_SB(0, 0), b2, voffB);
            PG8_BAR; PG8_WAIT_L(0); PG8_MMA(0, 1, At, B1); PG8_BAR;
            PG8_LDA(At, 0, 1); PG8_STAGE(PG8_SA(0, 0), a2, voffA);
            PG8_BAR; PG8_WAIT_L(0); PG8_MMA(1, 0, At, B0); PG8_BAR; PG8_SCHED;
            PG8_STAGE(PG8_SB(0, 1), b2 + hstepB, voffB);
            PG8_WAIT_V(6); PG8_BAR; PG8_MMA(1, 1, At, B1); PG8_BAR;
            PG8_LDB(B0, 1, 0); PG8_SCHED; PG8_LDA(At, 1, 0); PG8_STAGE(PG8_SA(0, 1), a2 + hstepA, voffA);
            PG8_WAIT_L(8); PG8_BAR; PG8_WAIT_L(0); PG8_MMA(0, 0, At, B0); PG8_BAR; PG8_SCHED;
            PG8_LDB(B1, 1, 1); PG8_STAGE(PG8_SB(1, 0), b3, voffB);
            PG8_BAR; PG8_WAIT_L(0); PG8_MMA(0, 1, At, B1); PG8_BAR;
            PG8_LDA(At, 1, 1); PG8_STAGE(PG8_SA(1, 0), a3, voffA);
            PG8_BAR; PG8_WAIT_L(0); PG8_MMA(1, 0, At, B0); PG8_BAR; PG8_SCHED;
            PG8_STAGE(PG8_SB(1, 1), b3 + hstepB, voffB);
            PG8_WAIT_V(6); PG8_BAR; PG8_MMA(1, 1, At, B1); PG8_BAR;
            }
        }
        if constexpr (ALIGN_EPI) { if (wr == 0) PG8_BAR; }
        if constexpr (!Epi::AFTER_DRAIN) { E(acc, cur, wr, wc, fr, fq); S.done(cur); }
        if (!has_next) break;
#pragma unroll
        for (int a = 0; a < 2; ++a)
#pragma unroll
            for (int b = 0; b < 2; ++b)
#pragma unroll
                for (int m = 0; m < 4; ++m)
#pragma unroll
                    for (int n = 0; n < 2; ++n) acc[a][b][m][n] = (f32x4){0.f, 0.f, 0.f, 0.f};
        cur = nxt; cA = nA; cB = nB; ++ui;
        if constexpr (ALIGN_EPI) { if (wr == 1) PG8_BAR; }
    }
    PG8_WAIT_V(0);
    if constexpr (!ALIGN_EPI) { if (wr == 0) PG8_BAR; }
    PG8_BAR;
    if constexpr (Epi::AFTER_DRAIN) { E.fused(acc, cur, wr, wc, fr, fq, lds, wid, lane); S.done(cur); }
#undef PG8_SA
#undef PG8_SB
#undef PG8_STAGE
#undef PG8_LDA
#undef PG8_LDB
#undef PG8_MMA
#undef PG8_WAIT_V
#undef PG8_WAIT_L
#undef PG8_BAR
#undef PG8_SCHED
}
}

constexpr int NWAVES = 8;
constexpr int DM = 4096, EI = 8192, BATCH = 4, SEQ = 2048, MTOK = BATCH * SEQ;
constexpr int CHUNK = 128, NHEAD = 16, HDIM = EI / NHEAD;
constexpr int NGRP = 4, GWID = EI / NGRP;
constexpr float EPS = 1e-6f;
constexpr int NST = 64;
constexpr int NPH = 10;
static_assert(MTOK % 256 == 0 && SEQ % CHUNK == 0 && SEQ % 256 == 0, "tiling");

constexpr size_t MiB = 1u << 20;
constexpr size_t WS_CTL = 0, CTL_ZERO_BYTES = 64 * 1024;
constexpr size_t WS_W1UZ = 1 * MiB;
constexpr size_t WS_W1V  = WS_W1UZ + (size_t)2 * EI * DM * 2;
constexpr size_t WS_W2   = WS_W1V + (size_t)EI * DM * 2;
constexpr size_t WS_W3   = WS_W2 + (size_t)DM * EI * 2;
constexpr size_t WS_W4   = WS_W3 + (size_t)2 * EI * DM * 2;
constexpr size_t WS_W5   = WS_W4 + (size_t)EI * GWID * 2;
constexpr size_t WS_H    = WS_W5 + (size_t)DM * EI * 2;
constexpr size_t WS_B0   = WS_H + (size_t)MTOK * DM * 2;
constexpr size_t WS_B1   = WS_B0 + (size_t)MTOK * EI * 2;
constexpr size_t WS_B2   = WS_B1 + (size_t)MTOK * EI * 2;
constexpr size_t WS_M    = WS_B2 + (size_t)MTOK * EI * 2;
constexpr size_t WS_ST   = WS_M + (size_t)MTOK * DM * 2;
constexpr size_t WS_DBG  = WS_ST + (size_t)NST * MTOK * 8;
constexpr size_t WS_END  = WS_DBG + (size_t)MTOK * 8;
constexpr int CW_BAR = 4096;

constexpr int RING_OFF = 0, RING_BYTES = 131072;
constexpr int LDSCTL_OFF = RING_BYTES, MISC_OFF = LDSCTL_OFF + 320;
constexpr int LDS_BYTES = 147456;
static_assert(MISC_OFF + 128 <= LDS_BYTES, "LDS map");

#define GAS __attribute__((address_space(1)))
#define LAS __attribute__((address_space(3)))
typedef unsigned short bf16;
typedef unsigned v4u __attribute__((ext_vector_type(4)));
typedef float f32x4 __attribute__((ext_vector_type(4)));
typedef short bf16x8 __attribute__((ext_vector_type(8)));
typedef GAS unsigned gu32;
typedef GAS unsigned long long gu64;
#define RLX_AGENT __ATOMIC_RELAXED, __HIP_MEMORY_SCOPE_AGENT
#define LDS_WAIT() asm volatile("s_waitcnt lgkmcnt(0)" ::: "memory")
#define VM_WAIT() asm volatile("s_waitcnt vmcnt(0)" ::: "memory")
__device__ __forceinline__ unsigned long long rt() { return __builtin_amdgcn_s_memrealtime(); }
__device__ __forceinline__ unsigned f2bf(float f) { unsigned u = __builtin_bit_cast(unsigned, f); return (u + 0x7fffu + ((u >> 16) & 1u)) >> 16; }
__device__ __forceinline__ unsigned pk2(float lo, float hi) { return f2bf(lo) | (f2bf(hi) << 16); }

#define XB_TMO      128
#define XB_XCNT(j)  (256  + 64 * (j))
#define XB_XSUB(j)  (1280 + 64 * (j))
#define XB_XGEN(j)  (2304 + 64 * (j))
#define XB_TOP      3328
#define XB_TOPGEN   3392
#define XCD_BAR_WORDS 3456
#define XB_SPIN_CAP (1u << 18)

__device__ __forceinline__ unsigned xb_ld(unsigned* p)              { return __hip_atomic_load(p, __ATOMIC_RELAXED, __HIP_MEMORY_SCOPE_AGENT); }
__device__ __forceinline__ unsigned xb_add(unsigned* p, unsigned v) { return __hip_atomic_fetch_add(p, v, __ATOMIC_RELAXED, __HIP_MEMORY_SCOPE_AGENT); }
__device__ __forceinline__ unsigned xb_xcc_id() { return (unsigned)__builtin_amdgcn_s_getreg((3 << 11) | 20) & 0xFu; }
#define XB_SPIN(cond, bar) do { unsigned _sp = 0; while (cond) { __builtin_amdgcn_s_sleep(1); \
    if ((++_sp & 255u) == 0u) { if (xb_ld(&(bar)[XB_TMO])) break; if (_sp > XB_SPIN_CAP) { atomicAdd(&(bar)[XB_TMO], 1u); break; } } } } while (0)

struct XcdBarrier {
    unsigned* bar; unsigned x;
    volatile LAS unsigned* st;
};

__device__ __forceinline__ XcdBarrier xcd_barrier_post(unsigned* bar, volatile LAS unsigned* st) {
    XcdBarrier b; b.bar = bar; b.x = xb_xcc_id(); b.st = st;
    if (threadIdx.x == 0) (void)xb_add(&bar[XB_XCNT(b.x)], 1u);
    return b;
}
__device__ __forceinline__ void xcd_barrier_complete(unsigned* bar, unsigned x, unsigned& nloc, unsigned& nx) {
    const unsigned G = gridDim.x * gridDim.y * gridDim.z;
    unsigned sum, cnt, mine, sp = 0u;
    for (;;) {
        sum = 0u; cnt = 0u; mine = 0u;
#pragma unroll
        for (unsigned j = 0; j < 16; ++j) { const unsigned c = xb_ld(&bar[XB_XCNT(j)]); sum += c; cnt += (c > 0u) ? 1u : 0u; mine = (j == x) ? c : mine; }
        if (sum == G) break;
        __builtin_amdgcn_s_sleep(1);
        if ((++sp & 255u) == 0u) { if (xb_ld(&bar[XB_TMO])) break; if (sp > XB_SPIN_CAP) { atomicAdd(&bar[XB_TMO], 1u); break; } }
    }
    nloc = mine > 0u ? mine : 1u; nx = cnt > 0u ? cnt : 1u;
}

__device__ __forceinline__ void xcd_barrier(const XcdBarrier& b) {
    asm volatile("s_waitcnt vmcnt(0)" ::: "memory");
    __syncthreads();
    if (threadIdx.x == 0) {
        unsigned* bar = b.bar;
        __builtin_amdgcn_s_waitcnt(0);
        unsigned nloc = b.st[0], nx = b.st[1];
        if (nloc == 0u) { xcd_barrier_complete(bar, b.x, nloc, nx); b.st[0] = nloc; b.st[1] = nx; }
        const unsigned old = xb_add(&bar[XB_XSUB(b.x)], 1u);
        const unsigned gen = old / nloc;
        if (old + 1u == (gen + 1u) * nloc) {
            __builtin_amdgcn_fence(__ATOMIC_RELEASE, "agent");
            asm volatile("s_waitcnt vmcnt(0)" ::: "memory");
            const unsigned og = xb_add(&bar[XB_TOP], 1u);
            const unsigned tg = og / nx;
            if (og + 1u == (tg + 1u) * nx) xb_add(&bar[XB_TOPGEN], 1u);
            else XB_SPIN(xb_ld(&bar[XB_TOPGEN]) == tg, bar);
            __builtin_amdgcn_fence(__ATOMIC_ACQUIRE, "agent");
            xb_add(&bar[XB_XGEN(b.x)], 1u);
            asm volatile("s_waitcnt vmcnt(0)" ::: "memory");
        } else {
            XB_SPIN(xb_ld(&bar[XB_XGEN(b.x)]) == gen, bar);
            __builtin_amdgcn_fence(__ATOMIC_ACQUIRE, "agent");
            asm volatile("s_waitcnt vmcnt(0)" ::: "memory");
        }
    }
    __syncthreads();
}

enum { IN_X = 0, IN_PRE, IN_POST, IN_AWIN, IN_ALNG, IN_ALNB, IN_AWS, IN_ABS, IN_AWOUT, IN_BWIN, IN_BWGRP, IN_BBGRP, IN_BSCALE, IN_BWOUT, N_IN };
struct Args { const float* in[N_IN]; float* out; unsigned char* ws; int ph_lo, ph_hi; };
struct Frame {
    LAS unsigned char* lds;
    volatile LAS unsigned* MISC;
    gu32* ctl;
    int tid, lane, wave;
    int vcu, G;
};
__device__ __forceinline__ float wave_sum(float v) {
#pragma unroll
    for (int o = 1; o < 64; o <<= 1) v += __shfl_xor(v, o);
    return v;
}
__device__ __forceinline__ float dot4(f32x4 a, f32x4 b) { return (a.x * b.x + a.y * b.y) + (a.z * b.z + a.w * b.w); }
using pg8::cvt_pk_bf16; using pg8::pack8; using pg8::unpk_lo; using pg8::unpk_hi; using pg8::u32x4; using pg8::f32x2;

__device__ __forceinline__ void transpose_item(const float* W, int ldw, int K, int n0, bf16* WT, int drow0, int k0, LAS float* scr, int lane) {
#pragma unroll 8
    for (int i = 0; i < 32; ++i) { const int kk = 2 * i + (lane >> 5); scr[kk * 33 + (lane & 31)] = W[(size_t)(k0 + kk) * ldw + n0 + (lane & 31)]; }
    LDS_WAIT(); asm volatile("" ::: "memory");
    const int c = lane & 7;
#pragma unroll
    for (int j = 0; j < 4; ++j) { const int n = (lane >> 3) + 8 * j; const LAS float* s = scr + (8 * c) * 33 + n;
        v4u o; o.x = cvt_pk_bf16(s[0 * 33], s[1 * 33]); o.y = cvt_pk_bf16(s[2 * 33], s[3 * 33]); o.z = cvt_pk_bf16(s[4 * 33], s[5 * 33]); o.w = cvt_pk_bf16(s[6 * 33], s[7 * 33]);
        *(GAS v4u*)(WT + (size_t)(drow0 + n) * K + k0 + 8 * c) = o; }
    LDS_WAIT(); asm volatile("" ::: "memory");
}
__device__ __forceinline__ void rms_row_to_bf16(const float* xrow, const float* g, bf16* orow, int lane) {
    const GAS f32x4* xr = (const GAS f32x4*)xrow + lane;
    f32x4 v[16]; float s = 0.f;
#pragma unroll
    for (int j = 0; j < 16; ++j) { v[j] = xr[64 * j]; s += dot4(v[j], v[j]); }
    const float rstd = 1.f / sqrtf(wave_sum(s) * (1.f / DM) + EPS);
    const GAS f32x4* gr = (const GAS f32x4*)g + lane;
    GAS unsigned long long* o8 = (GAS unsigned long long*)orow + lane;
#pragma unroll
    for (int j = 0; j < 16; ++j) { const f32x4 o = v[j] * rstd * gr[64 * j];
        o8[64 * j] = (unsigned long long)cvt_pk_bf16(o.x, o.y) | ((unsigned long long)cvt_pk_bf16(o.z, o.w) << 32); }
}
__device__ __forceinline__ void p0_prologue(const Args& a, Frame& F) {
    LAS float* scr = (LAS float*)(F.lds + RING_OFF + F.wave * 16384);
    const int gw = F.vcu * NWAVES + F.wave, NGW = F.G * NWAVES, lane = F.lane;
    constexpr int I0 = (DM / 64) * (2 * EI / 32), I1 = (DM / 64) * (EI / 32), I2 = (EI / 64) * (DM / 32), I3 = (DM / 64) * (2 * EI / 32), I4G = (GWID / 64) * (GWID / 32), I4 = NGRP * I4G, I5 = I2;
    constexpr int NITEMS = I0 + I1 + I2 + I3 + I4 + I5;
    for (int it = gw; it < NITEMS; it += NGW) {
        int r = it;
        if (r < I0) { constexpr int nbk = 2 * EI / 32; const int kb = r / nbk, nb = r % nbk, t = nb >> 3, jb = nb & 7;
            const int n0 = (jb < 4) ? 128 * t + 32 * jb : 2 * EI + 128 * t + 32 * (jb - 4);
            transpose_item(a.in[IN_AWIN], 3 * EI, DM, n0, (bf16*)(a.ws + WS_W1UZ), 32 * nb, 64 * kb, scr, lane); continue; } r -= I0;
        if (r < I1) { constexpr int nbk = EI / 32; const int kb = r / nbk, nb = r % nbk;
            transpose_item(a.in[IN_AWIN], 3 * EI, DM, EI + 32 * nb, (bf16*)(a.ws + WS_W1V), 32 * nb, 64 * kb, scr, lane); continue; } r -= I1;
        if (r < I2) { constexpr int nbk = DM / 32; const int kb = r / nbk, nb = r % nbk;
            transpose_item(a.in[IN_AWOUT], DM, EI, 32 * nb, (bf16*)(a.ws + WS_W2), 32 * nb, 64 * kb, scr, lane); continue; } r -= I2;
        if (r < I3) { constexpr int nbk = 2 * EI / 32; const int kb = r / nbk, nb = r % nbk;
            transpose_item(a.in[IN_BWIN], 2 * EI, DM, 32 * nb, (bf16*)(a.ws + WS_W3), 32 * nb, 64 * kb, scr, lane); continue; } r -= I3;
        if (r < I4) { constexpr int nbk = GWID / 32; const int g = r / I4G; r -= g * I4G; const int kb = r / nbk, nb = r % nbk;
            transpose_item(a.in[IN_BWGRP] + (size_t)g * GWID * GWID, GWID, GWID, 32 * nb, (bf16*)(a.ws + WS_W4) + (size_t)g * GWID * GWID, 32 * nb, 64 * kb, scr, lane); continue; } r -= I4;
        { constexpr int nbk = DM / 32; const int kb = r / nbk, nb = r % nbk;
            transpose_item(a.in[IN_BWOUT], DM, EI, 32 * nb, (bf16*)(a.ws + WS_W5), 32 * nb, 64 * kb, scr, lane); }
    }
    for (int m = gw; m < MTOK; m += NGW) rms_row_to_bf16(a.in[IN_X] + (size_t)m * DM, a.in[IN_PRE], (bf16*)(a.ws + WS_H) + (size_t)m * DM, lane);
}

__device__ __forceinline__ void sgu_phase(const Args& a, Frame& F) {
    constexpr int WP_PITCH = 272, WP_BYTES = 128 * WP_PITCH;
    constexpr int OFF_CV = 2 * WP_BYTES, OFF_MU = OFF_CV + 2 * 3 * 128 * 4, OFF_RS = OFF_MU + 512, OFF_PART = OFF_RS + 512;
    static_assert(OFF_PART + 4096 <= RING_BYTES, "sgu LDS");
    LAS unsigned char* L = F.lds + RING_OFF;
    LAS float* MU = (LAS float*)(L + OFF_MU); LAS float* RS = (LAS float*)(L + OFF_RS); LAS float* PART = (LAS float*)(L + OFF_PART);
    const float* ST = (const float*)(a.ws + WS_ST); const bf16* GVT = (const bf16*)(a.ws + WS_B1); const bf16* UZ = (const bf16*)(a.ws + WS_B0); bf16* Y = (bf16*)(a.ws + WS_B2);
    const float* lng = a.in[IN_ALNG]; const float* lnb = a.in[IN_ALNB]; const float* wsp = a.in[IN_AWS]; const float* bsv = a.in[IN_ABS];
    const int tid = F.tid, lane = F.lane, wave = F.wave, fr = lane & 15, fq = lane >> 4;
    for (int unit = blockIdx.x; unit < (MTOK / CHUNK) * 4; unit += F.G) {
        const int ck = unit >> 2, hg = unit & 3, R0 = ck * CHUNK;
        { const int r = tid & 127, q = tid >> 7; float s = 0.f, ss = 0.f;
#pragma unroll
            for (int j = 0; j < NST / 4; ++j) { const f32x2 p = *(const GAS f32x2*)(ST + ((size_t)(q * (NST / 4) + j) * MTOK + R0 + r) * 2); s += p.x; ss += p.y; }
            PART[(q * 128 + r) * 2] = s; PART[(q * 128 + r) * 2 + 1] = ss; }
        __syncthreads();
        if (tid < 128) { float s = 0.f, ss = 0.f;
#pragma unroll
            for (int q = 0; q < 4; ++q) { s += PART[(q * 128 + tid) * 2]; ss += PART[(q * 128 + tid) * 2 + 1]; }
            const float mean = s * (1.f / EI); float var = ss * (1.f / EI) - mean * mean; var = var > 0.f ? var : 0.f;
            MU[tid] = mean; RS[tid] = 1.f / sqrtf(var + EPS); }
        __syncthreads();
        for (int hh = 0; hh < 4; ++hh) {
            const int h = hg * 4 + hh, buf = hh & 1;
            LAS unsigned char* WP = L + buf * WP_BYTES; LAS float* CV = (LAS float*)(L + OFF_CV) + buf * 384;
            { const int t = tid >> 2, part = tid & 3, s0 = 32 * part;
                const GAS f32x4* wrow = (const GAS f32x4*)(wsp + ((size_t)h * CHUNK + t) * CHUNK + s0);
                float c1 = 0.f, c2 = 0.f;
#pragma unroll
                for (int i = 0; i < 4; ++i) {
                    const f32x4 wa = wrow[2 * i], wb = wrow[2 * i + 1];
                    const f32x4 ra = *(const LAS f32x4*)(RS + s0 + 8 * i), rb = *(const LAS f32x4*)(RS + s0 + 8 * i + 4);
                    const f32x4 ma = *(const LAS f32x4*)(MU + s0 + 8 * i), mb = *(const LAS f32x4*)(MU + s0 + 8 * i + 4);
                    f32x4 ca, cb;
#pragma unroll
                    for (int e = 0; e < 4; ++e) { ca[e] = (s0 + 8 * i + e <= t) ? wa[e] : 0.f; cb[e] = (s0 + 8 * i + 4 + e <= t) ? wb[e] : 0.f; }
                    c2 += (ca.x + ca.y) + (ca.z + ca.w) + (cb.x + cb.y) + (cb.z + cb.w);
                    const u32x4 pk = pack8(ca * ra, cb * rb);
                    c1 += dot4(unpk_lo(pk), ma) + dot4(unpk_hi(pk), mb);
                    *(LAS u32x4*)(WP + t * WP_PITCH + (s0 + 8 * i) * 2) = pk; }
                c1 += __shfl_xor(c1, 1); c1 += __shfl_xor(c1, 2); c2 += __shfl_xor(c2, 1); c2 += __shfl_xor(c2, 2);
                if (part == 0) { CV[t] = c1; CV[128 + t] = c2; CV[256 + t] = bsv[h * CHUNK + t]; } }
            __syncthreads();
            const int chb = h * HDIM + wave * 64;
            bf16x8 Gf[4][4];
#pragma unroll
            for (int nd = 0; nd < 4; ++nd) { const int ch = chb + 32 * (nd >> 1) + 8 * (fr >> 2) + 4 * (nd & 1) + (fr & 3);
#pragma unroll
                for (int ks = 0; ks < 4; ++ks) Gf[nd][ks] = *(const GAS bf16x8*)(GVT + (size_t)ch * MTOK + R0 + 32 * ks + 8 * fq); }
            f32x4 lg[2][2], lb[2][2];
#pragma unroll
            for (int p = 0; p < 2; ++p)
#pragma unroll
                for (int hf = 0; hf < 2; ++hf) { lg[p][hf] = *(const GAS f32x4*)(lng + chb + 32 * p + 8 * fq + 4 * hf); lb[p][hf] = *(const GAS f32x4*)(lnb + chb + 32 * p + 8 * fq + 4 * hf); }
#pragma unroll 1
            for (int th = 0; th < 2; ++th) {
                f32x4 acc[4][4];
#pragma unroll
                for (int nd = 0; nd < 4; ++nd)
#pragma unroll
                    for (int mq = 0; mq < 4; ++mq) acc[nd][mq] = (f32x4){0.f, 0.f, 0.f, 0.f};
#pragma unroll
                for (int mq = 0; mq < 4; ++mq) { const int mt = 4 * th + mq;
#pragma unroll
                    for (int ks = 0; ks < 4; ++ks) if (ks <= mt / 2) {
                        const bf16x8 wf = *(const LAS bf16x8*)(WP + (16 * mt + fr) * WP_PITCH + (32 * ks + 8 * fq) * 2);
#pragma unroll
                        for (int nd = 0; nd < 4; ++nd) acc[nd][mq] = __builtin_amdgcn_mfma_f32_16x16x32_bf16(Gf[nd][ks], wf, acc[nd][mq], 0, 0, 0); } }
#pragma unroll
                for (int mq = 0; mq < 4; ++mq) { const int t = 16 * (4 * th + mq) + fr; const float c1 = CV[t], c2 = CV[128 + t], bs = CV[256 + t];
#pragma unroll
                    for (int p = 0; p < 2; ++p) { const size_t off = (size_t)(R0 + t) * EI + chb + 32 * p + 8 * fq;
                        const u32x4 uz = *(const GAS u32x4*)(UZ + off);
                        const f32x4 sv0 = lg[p][0] * (acc[2 * p][mq] - c1) + (lb[p][0] * c2 + bs), sv1 = lg[p][1] * (acc[2 * p + 1][mq] - c1) + (lb[p][1] * c2 + bs);
                        *(GAS u32x4*)(Y + off) = pack8(unpk_lo(uz) * sv0, unpk_hi(uz) * sv1); } }
            }
        }
        __syncthreads();
    }
}

template <bool FINAL>
__device__ __forceinline__ void norm_phase(const bf16* M, const float* xin, float* xout, const float* gpost, const float* gpre, bf16* H, Frame& F) {
    const int gw = F.vcu * NWAVES + F.wave, NGW = F.G * NWAVES, lane = F.lane;
    for (int m = gw; m < MTOK; m += NGW) {
        const GAS u32x4* mr = (const GAS u32x4*)(M + (size_t)m * DM) + lane;
        u32x4 mv[8]; float ss = 0.f;
#pragma unroll
        for (int j = 0; j < 8; ++j) { mv[j] = mr[64 * j]; const f32x4 lo = unpk_lo(mv[j]), hi = unpk_hi(mv[j]); ss += dot4(lo, lo) + dot4(hi, hi); }
        const float rm = 1.f / sqrtf(wave_sum(ss) * (1.f / DM) + EPS);
        f32x4 x1[16]; float s2 = 0.f;
#pragma unroll
        for (int j = 0; j < 8; ++j) { const size_t e0 = (size_t)8 * (lane + 64 * j);
            const f32x4 xa = *(const GAS f32x4*)(xin + (size_t)m * DM + e0), xb = *(const GAS f32x4*)(xin + (size_t)m * DM + e0 + 4);
            const f32x4 ga = *(const GAS f32x4*)(gpost + e0), gb = *(const GAS f32x4*)(gpost + e0 + 4);
            x1[2 * j] = xa + unpk_lo(mv[j]) * rm * ga; x1[2 * j + 1] = xb + unpk_hi(mv[j]) * rm * gb;
            s2 += dot4(x1[2 * j], x1[2 * j]) + dot4(x1[2 * j + 1], x1[2 * j + 1]);
            *(GAS f32x4*)(xout + (size_t)m * DM + e0) = x1[2 * j]; *(GAS f32x4*)(xout + (size_t)m * DM + e0 + 4) = x1[2 * j + 1]; }
        if constexpr (!FINAL) {
            const float rx = 1.f / sqrtf(wave_sum(s2) * (1.f / DM) + EPS);
#pragma unroll
            for (int j = 0; j < 8; ++j) { const size_t e0 = (size_t)8 * (lane + 64 * j);
                const f32x4 ga = *(const GAS f32x4*)(gpre + e0), gb = *(const GAS f32x4*)(gpre + e0 + 4);
                *(GAS u32x4*)(H + (size_t)m * DM + e0) = pack8(x1[2 * j] * rx * ga, x1[2 * j + 1] * rx * gb); }
        }
    }
}

template <int W>
__device__ __forceinline__ void pool_unit(const bf16* P, bf16* O, int R0, int c0) {
    const int tseq0 = R0 & (SEQ - 1);
    f32x4 Sa = (f32x4){0.f, 0.f, 0.f, 0.f}, Sb = Sa; u32x4 ring[W];
#pragma unroll
    for (int j = 0; j < W; ++j) {
        u32x4 v = (u32x4){0u, 0u, 0u, 0u};
        if (tseq0 - W + j >= 0) v = *(const GAS u32x4*)(P + (size_t)(R0 - W + j) * EI + c0);
        ring[j] = v; if (j >= 1) { Sa += unpk_lo(v); Sb += unpk_hi(v); } }
    for (int t = 0; t < 64; t += W) {
#pragma unroll
        for (int j = 0; j < W; ++j) {
            const size_t off = (size_t)(R0 + t + j) * EI + c0;
            const u32x4 cur = *(const GAS u32x4*)(P + off);
            const f32x4 ca = unpk_lo(cur), cb = unpk_hi(cur);
            Sa += ca; Sb += cb;
            const int pos = tseq0 + t + j + 1; const float inv = 1.f / (float)(pos < W ? pos : W);
            *(GAS u32x4*)(O + off) = pack8(Sa * inv - ca, Sb * inv - cb);
            ring[j] = cur;
            const u32x4 old = ring[(j + 1) % W]; Sa -= unpk_lo(old); Sb -= unpk_hi(old);
        }
    }
}
__device__ __forceinline__ void pool_phase(const Args& a, Frame& F) {
    const bf16* P = (const bf16*)(a.ws + WS_B1); bf16* O = (bf16*)(a.ws + WS_B2);
    const int gw = F.vcu * NWAVES + F.wave, NGW = F.G * NWAVES;
    for (int wu = gw; wu < (MTOK / 64) * (EI / 512); wu += NGW) {
        const int rb = wu >> 4, cb = wu & 15, R0 = 64 * rb, c0 = 512 * cb + 8 * F.lane, g = cb >> 2;
        if (g == 0) pool_unit<2>(P, O, R0, c0); else if (g == 1) pool_unit<4>(P, O, R0, c0); else if (g == 2) pool_unit<8>(P, O, R0, c0); else pool_unit<16>(P, O, R0, c0);
    }
}

__global__ void __launch_bounds__(NWAVES * 64, 2) skel_fwd(Args args) {
    extern __shared__ __attribute__((aligned(16))) unsigned char lds[];
    Frame F;
    F.lds = (LAS unsigned char*)lds;
    F.MISC = (volatile LAS unsigned*)(F.lds + MISC_OFF);
    F.tid = threadIdx.x; F.lane = F.tid & 63; F.wave = __builtin_amdgcn_readfirstlane(F.tid >> 6);
    F.G = gridDim.x; { const int bx = blockIdx.x; F.vcu = (F.G % 8 == 0) ? (bx % 8) * (F.G / 8) + bx / 8 : bx; }
    unsigned char* ws = args.ws;
    F.ctl = (gu32*)(ws + WS_CTL);
    for (int u = F.tid; u < (LDS_BYTES - LDSCTL_OFF) / 4; u += NWAVES * 64) ((LAS unsigned*)(F.lds + LDSCTL_OFF))[u] = 0u;
    __syncthreads();
    XcdBarrier bar = xcd_barrier_post((unsigned*)(F.ctl + CW_BAR), F.MISC + 8);
    const int lo = args.ph_lo, hi = args.ph_hi;
#ifndef PH_MASK
#define PH_MASK 0x3ff
#endif
#define IN(k) ((((PH_MASK) >> (k)) & 1) && lo <= (k) && (k) < hi)
#define BOTH(k) (IN(k) && IN((k) + 1))
    bf16* const W1UZ = (bf16*)(ws + WS_W1UZ); bf16* const W1V = (bf16*)(ws + WS_W1V); bf16* const W2 = (bf16*)(ws + WS_W2); bf16* const W3 = (bf16*)(ws + WS_W3);
    bf16* const W4 = (bf16*)(ws + WS_W4); bf16* const W5 = (bf16*)(ws + WS_W5); bf16* const Hb = (bf16*)(ws + WS_H); bf16* const B0 = (bf16*)(ws + WS_B0);
    bf16* const B1 = (bf16*)(ws + WS_B1); bf16* const B2 = (bf16*)(ws + WS_B2); bf16* const Mb = (bf16*)(ws + WS_M); float* const ST = (float*)(ws + WS_ST);

    if (IN(0)) { p0_prologue(args, F); if (BOTH(0)) xcd_barrier(bar); }

    if (IN(1)) {
        { pg8::Gemm g{Hb, W1UZ, DM, DM, DM, 0, 0}; pg8::StaticOrder S; S.init(MTOK, 2 * EI, F.G, (int)blockIdx.x);
          pg8::EpiUZ E{B0, EI};
          pg8::gemm_phase<pg8::EpiUZ, pg8::StaticOrder, true, true>(F.lds + RING_OFF, g, S, E); }
        __syncthreads();
        { pg8::Gemm g{W1V, Hb, DM, DM, DM, 0, 0}; pg8::StaticOrder S; S.init(EI, MTOK, F.G, (int)blockIdx.x);
          pg8::EpiGvT E{B1, MTOK, ST, MTOK};
          pg8::gemm_phase<pg8::EpiGvT, pg8::StaticOrder, true, true>(F.lds + RING_OFF, g, S, E); }
        if (BOTH(1)) xcd_barrier(bar);
    }

    if (IN(2)) { sgu_phase(args, F); if (BOTH(2)) xcd_barrier(bar); }

    if (IN(3)) {
        pg8::Gemm g{B2, W2, EI, EI, EI, 0, 0}; pg8::StaticOrder S; S.init(MTOK, DM, F.G, (int)blockIdx.x);
        pg8::EpiPlain E{Mb, DM};
        pg8::gemm_phase<pg8::EpiPlain, pg8::StaticOrder, true, true>(F.lds + RING_OFF, g, S, E);
        if (BOTH(3)) xcd_barrier(bar);
    }

    if (IN(4)) { norm_phase<false>(Mb, args.in[IN_X], args.out, args.in[IN_POST], args.in[IN_PRE] + DM, Hb, F); if (BOTH(4)) xcd_barrier(bar); }

    if (IN(5)) {
        pg8::Gemm g{Hb, W3, DM, DM, DM, 0, 0}; pg8::StaticOrder S; S.init(MTOK, 2 * EI, F.G, (int)blockIdx.x);
        pg8::EpiPZ E{B1, B0, EI, EI / 256};
        pg8::gemm_phase<pg8::EpiPZ, pg8::StaticOrder, true, true>(F.lds + RING_OFF, g, S, E);
        if (BOTH(5)) xcd_barrier(bar);
    }

    if (IN(6)) { pool_phase(args, F); if (BOTH(6)) xcd_barrier(bar); }

    if (IN(7)) {
        pg8::Gemm g{B2, W4, EI, GWID, GWID, GWID / 256, GWID}; pg8::StaticOrder S; S.init(MTOK, EI, F.G, (int)blockIdx.x);
        pg8::EpiMix E{B0, B1, EI, args.in[IN_BBGRP], args.in[IN_BSCALE]};
        pg8::gemm_phase<pg8::EpiMix, pg8::StaticOrder, true, true>(F.lds + RING_OFF, g, S, E);
        if (BOTH(7)) xcd_barrier(bar);
    }

    if (IN(8)) {
        pg8::Gemm g{B1, W5, EI, EI, EI, 0, 0}; pg8::StaticOrder S; S.init(MTOK, DM, F.G, (int)blockIdx.x);
        pg8::EpiPlain E{Mb, DM};
        pg8::gemm_phase<pg8::EpiPlain, pg8::StaticOrder, true, true>(F.lds + RING_OFF, g, S, E);
        if (BOTH(8)) xcd_barrier(bar);
    }

    if (IN(9)) {
        norm_phase<true>(Mb, args.out, args.out, args.in[IN_POST] + DM, nullptr, nullptr, F);
        if (__hip_atomic_load(F.ctl + CW_BAR + XB_TMO, RLX_AGENT) != 0u) {
            const int gw = F.vcu * NWAVES + F.wave, NGW = F.G * NWAVES; const float q = __builtin_nanf("");
            for (int m = gw; m < MTOK; m += NGW) { GAS f32x4* o = (GAS f32x4*)(args.out + (size_t)m * DM) + F.lane;
#pragma unroll
                for (int j = 0; j < 16; ++j) o[64 * j] = (f32x4){q, q, q, q}; } }
    }
#undef IN
#undef BOTH
}

#if NAIVE_MASK != 0
__device__ __forceinline__ bf16 nv_f2bf(float f) { unsigned u = __float_as_uint(f); u += 0x7fffu + ((u >> 16) & 1u); return (bf16)(u >> 16); }
__device__ __forceinline__ float nv_bf2f(bf16 b) { return __uint_as_float(((unsigned)b) << 16); }
__device__ __forceinline__ float nv_gelu(float v) { return 0.5f * v * (1.0f + erff(v * 0.70710678118654752f)); }
__device__ __forceinline__ float nv_silu(float v) { return v / (1.0f + expf(-v)); }
__global__ void nv_transpose(const float* W, int ldw, int K, int Nd, bf16* WT, int mode) {
    const size_t total = (size_t)Nd * K;
    for (size_t i = (size_t)blockIdx.x * blockDim.x + threadIdx.x; i < total; i += (size_t)gridDim.x * blockDim.x) {
        const int r = (int)(i / K), k = (int)(i % K); int c = r;
        if (mode == 1) { const int t = r >> 8, j = r & 255; c = j < 128 ? 128 * t + j : 2 * EI + 128 * t + (j - 128); }
        if (mode == 2) c = EI + r;
        WT[i] = nv_f2bf(W[(size_t)k * ldw + c]); }
}
__global__ void nv_rms_h(const float* x, const float* g, bf16* H) {
    const int m = blockIdx.x, lane = threadIdx.x; float s = 0.f;
    for (int c = lane; c < DM; c += 64) { const float v = x[(size_t)m * DM + c]; s += v * v; }
    for (int o = 1; o < 64; o <<= 1) s += __shfl_xor(s, o);
    const float rstd = 1.f / sqrtf(s / DM + EPS);
    for (int c = lane; c < DM; c += 64) H[(size_t)m * DM + c] = nv_f2bf(x[(size_t)m * DM + c] * rstd * g[c]);
}
struct NvUZ { bf16* U; bf16* Zt; __device__ void operator()(int r, int c, float v) const { const int t = c >> 8, j = c & 255;
    if (j < 128) U[(size_t)r * EI + 128 * t + j] = nv_f2bf(nv_gelu(v)); else Zt[(size_t)r * EI + 128 * t + (j - 128)] = nv_f2bf(nv_silu(v)); } };
struct NvGvT { bf16* O; __device__ void operator()(int r, int c, float v) const { O[(size_t)c * MTOK + r] = nv_f2bf(nv_gelu(v)); } };
struct NvPlain { bf16* O; int ldc; int pad; __device__ void operator()(int r, int c, float v) const { O[(size_t)r * ldc + c] = nv_f2bf(v); } };
struct NvPZ { bf16* P; bf16* SZ; __device__ void operator()(int r, int c, float v) const { if (c < EI) P[(size_t)r * EI + c] = nv_f2bf(v); else SZ[(size_t)r * EI + c - EI] = nv_f2bf(nv_silu(v)); } };
struct NvMix { const bf16* SZ; bf16* Y; const float* bgrp; const float* scale; int g; int pad; __device__ void operator()(int r, int c, float v) const { const int ch = g * GWID + c;
    Y[(size_t)r * EI + ch] = nv_f2bf((v + bgrp[ch]) * scale[ch] * nv_bf2f(SZ[(size_t)r * EI + ch])); } };
template <class Epi> __global__ void __launch_bounds__(256) nv_gemm(const bf16* A, int lda, const bf16* Bt, int ldb, int K, Epi epi) {
    __shared__ float As[16][65], Bs[16][65];
    const int tid = threadIdx.x, tx = tid & 15, ty = tid >> 4, row0 = blockIdx.y * 64, col0 = blockIdx.x * 64;
    float acc[4][4];
#pragma unroll
    for (int i = 0; i < 4; ++i)
#pragma unroll
        for (int j = 0; j < 4; ++j) acc[i][j] = 0.f;
    const int lr = tid >> 2, lk = (tid & 3) * 4;
    for (int k0 = 0; k0 < K; k0 += 16) {
#pragma unroll
        for (int i = 0; i < 4; ++i) { As[lk + i][lr] = nv_bf2f(A[(size_t)(row0 + lr) * lda + k0 + lk + i]); Bs[lk + i][lr] = nv_bf2f(Bt[(size_t)(col0 + lr) * ldb + k0 + lk + i]); }
        __syncthreads();
#pragma unroll
        for (int k = 0; k < 16; ++k) { float av[4], bv[4];
#pragma unroll
            for (int i = 0; i < 4; ++i) { av[i] = As[k][ty * 4 + i]; bv[i] = Bs[k][tx * 4 + i]; }
#pragma unroll
            for (int i = 0; i < 4; ++i)
#pragma unroll
                for (int j = 0; j < 4; ++j) acc[i][j] += av[i] * bv[j]; }
        __syncthreads();
    }
#pragma unroll
    for (int i = 0; i < 4; ++i)
#pragma unroll
        for (int j = 0; j < 4; ++j) epi(row0 + ty * 4 + i, col0 + tx * 4 + j, acc[i][j]);
}
__global__ void nv_mul(bf16* U, const bf16* Zt, size_t n) { for (size_t i = (size_t)blockIdx.x * blockDim.x + threadIdx.x; i < n; i += (size_t)gridDim.x * blockDim.x) U[i] = nv_f2bf(nv_bf2f(U[i]) * nv_bf2f(Zt[i])); }
__global__ void nv_stats(const bf16* GVT, float* ST) {
    const int tok = blockIdx.x * blockDim.x + threadIdx.x; if (tok >= MTOK) return; float s = 0.f, ss = 0.f;
    for (int ch = 0; ch < EI; ++ch) { const float v = nv_bf2f(GVT[(size_t)ch * MTOK + tok]); s += v; ss += v * v; }
    ST[(size_t)tok * 2] = s; ST[(size_t)tok * 2 + 1] = ss;
    for (int p = 1; p < NST; ++p) { ST[((size_t)p * MTOK + tok) * 2] = 0.f; ST[((size_t)p * MTOK + tok) * 2 + 1] = 0.f; }
}
__global__ void nv_murs(const float* ST, float* MR) {
    const int tok = blockIdx.x * blockDim.x + threadIdx.x; if (tok >= MTOK) return; float s = 0.f, ss = 0.f;
    for (int p = 0; p < NST; ++p) { s += ST[((size_t)p * MTOK + tok) * 2]; ss += ST[((size_t)p * MTOK + tok) * 2 + 1]; }
    const float mean = s / EI; float var = ss / EI - mean * mean; var = var > 0.f ? var : 0.f; MR[tok * 2] = mean; MR[tok * 2 + 1] = 1.f / sqrtf(var + EPS);
}
__global__ void nv_sgu(const bf16* GVT, const float* MR, const bf16* UZ, const float* lng, const float* lnb, const float* wsp, const float* bsv, bf16* Y) {
    const size_t total = (size_t)MTOK * EI;
    for (size_t i = (size_t)blockIdx.x * blockDim.x + threadIdx.x; i < total; i += (size_t)gridDim.x * blockDim.x) {
        const int ch = (int)(i / MTOK), tok = (int)(i % MTOK), h = ch / HDIM, t = tok & (CHUNK - 1), R0 = tok - t;
        float sv = 0.f;
        for (int s = 0; s <= t; ++s) { const float vn = (nv_bf2f(GVT[(size_t)ch * MTOK + R0 + s]) - MR[(R0 + s) * 2]) * MR[(R0 + s) * 2 + 1] * lng[ch] + lnb[ch];
            sv += wsp[((size_t)h * CHUNK + t) * CHUNK + s] * vn; }
        sv += bsv[h * CHUNK + t];
        Y[(size_t)tok * EI + ch] = nv_f2bf(nv_bf2f(UZ[(size_t)tok * EI + ch]) * sv); }
}
__global__ void nv_pool(const bf16* P, bf16* O) {
    const size_t total = (size_t)MTOK * EI;
    for (size_t i = (size_t)blockIdx.x * blockDim.x + threadIdx.x; i < total; i += (size_t)gridDim.x * blockDim.x) {
        const int tok = (int)(i / EI), ch = (int)(i % EI), g = ch / GWID, W = 2 << g, tseq = tok & (SEQ - 1), cnt = (tseq + 1 < W) ? tseq + 1 : W;
        float s = 0.f; for (int j = 0; j < cnt; ++j) s += nv_bf2f(P[(size_t)(tok - j) * EI + ch]);
        O[i] = nv_f2bf(s / (float)cnt - nv_bf2f(P[i])); }
}
static void launch_naive_phase(int k, const Args& a, hipStream_t stream) {
    unsigned char* ws = a.ws;
    bf16* W1UZ = (bf16*)(ws + WS_W1UZ); bf16* W1V = (bf16*)(ws + WS_W1V); bf16* W2 = (bf16*)(ws + WS_W2); bf16* W3 = (bf16*)(ws + WS_W3); bf16* W4 = (bf16*)(ws + WS_W4); bf16* W5 = (bf16*)(ws + WS_W5);
    bf16* Hb = (bf16*)(ws + WS_H); bf16* B0 = (bf16*)(ws + WS_B0); bf16* B1 = (bf16*)(ws + WS_B1); bf16* B2 = (bf16*)(ws + WS_B2); bf16* Mb = (bf16*)(ws + WS_M); float* ST = (float*)(ws + WS_ST); float* MR = (float*)(ws + WS_DBG);
    const dim3 blk(256);
    switch (k) {
    case 0:
        hipLaunchKernelGGL(nv_transpose, dim3(8192), blk, 0, stream, a.in[IN_AWIN], 3 * EI, DM, 2 * EI, W1UZ, 1);
        hipLaunchKernelGGL(nv_transpose, dim3(8192), blk, 0, stream, a.in[IN_AWIN], 3 * EI, DM, EI, W1V, 2);
        hipLaunchKernelGGL(nv_transpose, dim3(8192), blk, 0, stream, a.in[IN_AWOUT], DM, EI, DM, W2, 0);
        hipLaunchKernelGGL(nv_transpose, dim3(8192), blk, 0, stream, a.in[IN_BWIN], 2 * EI, DM, 2 * EI, W3, 0);
        for (int g = 0; g < NGRP; ++g) hipLaunchKernelGGL(nv_transpose, dim3(4096), blk, 0, stream, a.in[IN_BWGRP] + (size_t)g * GWID * GWID, GWID, GWID, GWID, W4 + (size_t)g * GWID * GWID, 0);
        hipLaunchKernelGGL(nv_transpose, dim3(8192), blk, 0, stream, a.in[IN_BWOUT], DM, EI, DM, W5, 0);
        hipLaunchKernelGGL(nv_rms_h, dim3(MTOK), dim3(64), 0, stream, a.in[IN_X], a.in[IN_PRE], Hb);
        break;
    case 1:
        hipLaunchKernelGGL(nv_gemm<NvUZ>, dim3(2 * EI / 64, MTOK / 64), blk, 0, stream, (const bf16*)Hb, DM, (const bf16*)W1UZ, DM, DM, NvUZ{B0, B2});
        hipLaunchKernelGGL(nv_mul, dim3(8192), blk, 0, stream, B0, (const bf16*)B2, (size_t)MTOK * EI);
        hipLaunchKernelGGL(nv_gemm<NvGvT>, dim3(EI / 64, MTOK / 64), blk, 0, stream, (const bf16*)Hb, DM, (const bf16*)W1V, DM, DM, NvGvT{B1});
        hipLaunchKernelGGL(nv_stats, dim3(MTOK / 256), blk, 0, stream, (const bf16*)B1, ST);
        break;
    case 2:
        hipLaunchKernelGGL(nv_murs, dim3(MTOK / 256), blk, 0, stream, (const float*)ST, MR);
        hipLaunchKernelGGL(nv_sgu, dim3(16384), blk, 0, stream, (const bf16*)B1, (const float*)MR, (const bf16*)B0, a.in[IN_ALNG], a.in[IN_ALNB], a.in[IN_AWS], a.in[IN_ABS], B2);
        break;
    case 3: hipLaunchKernelGGL(nv_gemm<NvPlain>, dim3(DM / 64, MTOK / 64), blk, 0, stream, (const bf16*)B2, EI, (const bf16*)W2, EI, EI, NvPlain{Mb, DM, 0}); break;
    case 5: hipLaunchKernelGGL(nv_gemm<NvPZ>, dim3(2 * EI / 64, MTOK / 64), blk, 0, stream, (const bf16*)Hb, DM, (const bf16*)W3, DM, DM, NvPZ{B1, B0}); break;
    case 6: hipLaunchKernelGGL(nv_pool, dim3(16384), blk, 0, stream, (const bf16*)B1, B2); break;
    case 7:
        for (int g = 0; g < NGRP; ++g) hipLaunchKernelGGL(nv_gemm<NvMix>, dim3(GWID / 64, MTOK / 64), blk, 0, stream, (const bf16*)B2 + (size_t)g * GWID, EI, (const bf16*)W4 + (size_t)g * GWID * GWID, GWID, GWID,
                                                          NvMix{(const bf16*)B0, B1, a.in[IN_BBGRP], a.in[IN_BSCALE], g, 0});
        break;
    case 8: hipLaunchKernelGGL(nv_gemm<NvPlain>, dim3(DM / 64, MTOK / 64), blk, 0, stream, (const bf16*)B1, EI, (const bf16*)W5, EI, EI, NvPlain{Mb, DM, 0}); break;
    default: break;
    }
}
#endif

extern "C" void kernel_launch(void* const* d_in, const int* in_sizes, int n_in, void* d_out, int out_size, void* d_ws, size_t ws_size, hipStream_t stream) {
    static int grid = 0;
    if (grid == 0) {
        if (n_in != N_IN || in_sizes[0] != MTOK * DM || out_size != MTOK * DM || ws_size < WS_END) {
            fprintf(stderr, "kernel_launch: built for %d inputs, x and out of %d floats, >= %zu bytes of workspace; got n_in %d, in0 %d, out %d, ws %zu; nothing launched\n", (int)N_IN, MTOK * DM, (size_t)WS_END, n_in, n_in > 0 ? in_sizes[0] : -1, out_size, ws_size); grid = -1; return; }
        int dev = 0, cus = 0, per_cu = 0;
        if (hipGetDevice(&dev) != hipSuccess || hipDeviceGetAttribute(&cus, hipDeviceAttributeMultiprocessorCount, dev) != hipSuccess) { fprintf(stderr, "kernel_launch: hipGetDevice / hipDeviceGetAttribute failed; nothing launched\n"); grid = -1; return; }
        if (hipFuncSetAttribute((const void*)skel_fwd, hipFuncAttributeMaxDynamicSharedMemorySize, LDS_BYTES) != hipSuccess) { fprintf(stderr, "kernel_launch: hipFuncSetAttribute failed (%d bytes of dynamic LDS); nothing launched\n", LDS_BYTES); grid = -1; return; }
        if (hipOccupancyMaxActiveBlocksPerMultiprocessor(&per_cu, (const void*)skel_fwd, NWAVES * 64, LDS_BYTES) != hipSuccess || per_cu < 1)
            fprintf(stderr, "kernel_launch: note: the occupancy query reports %d workgroups per CU; launching one per CU\n", per_cu);
        (void)hipGetLastError();
        grid = cus;
    }
    if (grid < 0) return;
    if (hipMemsetAsync((char*)d_ws + WS_CTL, 0, CTL_ZERO_BYTES, stream) != hipSuccess) { fprintf(stderr, "kernel_launch: hipMemsetAsync of the control words failed; nothing launched\n"); return; }
    Args a{};
    for (int i = 0; i < N_IN; ++i) a.in[i] = (const float*)d_in[i];
    a.out = (float*)d_out; a.ws = (unsigned char*)d_ws;
#if NAIVE_MASK == 0
    a.ph_lo = 0; a.ph_hi = NPH;
    hipLaunchKernelGGL(skel_fwd, dim3(grid), dim3(NWAVES * 64), LDS_BYTES, stream, a);
    { const hipError_t le = hipPeekAtLastError(); if (le != hipSuccess) fprintf(stderr, "kernel_launch: launch failed: %s (grid %d x %d threads, %d B LDS)\n", hipGetErrorName(le), grid, NWAVES * 64, LDS_BYTES); }
#else
    for (int k = 0; k < NPH; ++k) {
        if ((NAIVE_MASK >> k) & 1 && k != 4 && k != 9) { launch_naive_phase(k, a, stream); continue; }
        a.ph_lo = k; a.ph_hi = k + 1;
        hipLaunchKernelGGL(skel_fwd, dim3(grid), dim3(NWAVES * 64), LDS_BYTES, stream, a);
        const hipError_t le = hipPeekAtLastError(); if (le != hipSuccess) { fprintf(stderr, "kernel_launch: launch of phase %d failed: %s\n", k, hipGetErrorName(le)); break; }
    }
#endif
}
```

```cpp
#include <hip/hip_runtime.h>
#include <cstdio>
#include <cstdint>

#ifndef NAIVE_MASK
#define NAIVE_MASK 0
#endif
#ifndef REPEAT_MASK
#define REPEAT_MASK 0
#endif
#ifndef STAGGER
#define STAGGER 0
#endif
#ifndef SPREAD
#define SPREAD 1
#endif
#ifndef DELAY_P1_US
#define DELAY_P1_US 0
#endif
#ifndef GSP2
#define GSP2 true
#endif
#ifndef GSETPRIO
#define GSETPRIO 1
#endif
#ifndef GALIGN
#define GALIGN true
#endif
#ifndef WCOMB
#define WCOMB 1
#endif
#ifndef PROBE_EPI
#define PROBE_EPI 0
#endif
#ifndef PROBE_DUR
#define PROBE_DUR 0
#endif
#ifndef WDROP
#define WDROP 0
#endif
#ifndef X1BF16
#define X1BF16 1
#endif
#ifndef PROBE_CLK
#define PROBE_CLK 0
#endif

namespace pg8 {
#define PG8_LAS __attribute__((address_space(3)))
typedef unsigned short bf16_t;
typedef short bf16x8 __attribute__((ext_vector_type(8)));
typedef float f32x4 __attribute__((ext_vector_type(4)));
typedef unsigned u32x4 __attribute__((ext_vector_type(4)));
constexpr int BM = 256, BK = 64, HALF = 128, HTB = HALF * BK * 2  , STAGE_BYTES = 8 * HTB, NXCD = 8, WGM = 8;

__host__ __device__ __forceinline__ int lds_byte(int r, int c) { const int st = (r >> 4) * 2 + (c >> 5), rr = r & 15, cc = c & 31, ob = rr * 64 + cc * 2; return st * 1024 + (ob ^ (((ob >> 9) & 1) << 5)); }
__host__ __device__ __forceinline__ void stage_rc(int b, int& R, int& C) { const int st = b / 1024, sb = b % 1024, swz = sb ^ (((sb >> 9) & 1) << 5); R = (st >> 1) * 16 + swz / 64; C = (st & 1) * 32 + (swz % 64) / 2; }
__host__ __device__ __forceinline__ int perm32(int rho) { const int n = rho >> 4, i = rho & 15; return 8 * (i >> 2) + 4 * n + (i & 3); }

struct Unit { int pm, pn; };
struct Gemm { const bf16_t* A; const bf16_t* Bt; int lda, ldb, K; int agrp_tiles; size_t agrp_bytes; int bgrp_tiles; size_t bgrp_bytes;
    __device__ __forceinline__ size_t acol(int pn) const { return agrp_tiles ? (size_t)(pn / agrp_tiles) * agrp_bytes : (size_t)0; }
    __device__ __forceinline__ size_t bcol(int pm) const { return bgrp_tiles ? (size_t)(pm / bgrp_tiles) * bgrp_bytes : (size_t)0; } };

struct StaticOrder {
    int nM, nN, nwg, G, c;
    __host__ __device__ void init(int M, int N, int G_, int c_) { nM = M / BM; nN = N / BM; nwg = nM * nN; G = G_; c = c_; }
    __host__ __device__ bool next(int i, Unit& u) const {
        const long L = (long)i * G + c; if (L >= nwg) return false;
        int wgid = (int)L; { const int q = nwg / NXCD, r = nwg % NXCD, xcd = wgid % NXCD, off = wgid / NXCD; wgid = (xcd < r ? xcd * (q + 1) : r * (q + 1) + (xcd - r) * q) + off; }
        const int nig = WGM * nN, gid = wgid / nig, fm = gid * WGM, gsz = (nM - fm) < WGM ? (nM - fm) : WGM;
        u.pm = fm + ((wgid % nig) % gsz); u.pn = (wgid % nig) / gsz; return true;
    }
    __device__ __forceinline__ void a_ready(const Unit&) const {}
    __device__ __forceinline__ void done(const Unit&) const {}
};

__device__ __forceinline__ unsigned cvt_pk_bf16(float lo, float hi) { unsigned r; asm volatile("v_cvt_pk_bf16_f32 %0, %1, %2" : "=v"(r) : "v"(lo), "v"(hi)); return r; }
typedef float f32x2 __attribute__((ext_vector_type(2)));
__device__ __forceinline__ f32x2 gelu_pk(f32x2 v) {
    const f32x2 av = __builtin_elementwise_abs(v), d = av * 0.2316418882f + 1.0f;
    f32x2 t; t.x = __builtin_amdgcn_rcpf(d.x); t.y = __builtin_amdgcn_rcpf(d.y);
    f32x2 q = t * 0.5307027145f + (-0.7265760135f); q = q * t + 0.7107068705f; q = q * t + (-0.142248368f); q = q * t + 0.127414796f; q = q * t;
    const f32x2 s = (v * v) * (-0.72134752044f);
    f32x2 e; e.x = __builtin_amdgcn_exp2f(s.x); e.y = __builtin_amdgcn_exp2f(s.y);
    const f32x2 m = v * (q * e), r = v - m;
    f32x2 o; o.x = v.x < 0.f ? m.x : r.x; o.y = v.y < 0.f ? m.y : r.y; return o;
}

__device__ __forceinline__ float silu1(float z) { return z * __builtin_amdgcn_rcpf(1.0f + __builtin_amdgcn_exp2f(z * -1.4426950408889634f)); }
__device__ __forceinline__ f32x4 gelu4(f32x4 v) { const f32x2 a = gelu_pk((f32x2){v[0], v[1]}), b = gelu_pk((f32x2){v[2], v[3]}); return (f32x4){a.x, a.y, b.x, b.y}; }
__device__ __forceinline__ f32x4 silu4(f32x4 v) { return (f32x4){silu1(v[0]), silu1(v[1]), silu1(v[2]), silu1(v[3])}; }
__device__ __forceinline__ u32x4 pack8(f32x4 a, f32x4 b) { u32x4 w; w.x = cvt_pk_bf16(a[0], a[1]); w.y = cvt_pk_bf16(a[2], a[3]); w.z = cvt_pk_bf16(b[0], b[1]); w.w = cvt_pk_bf16(b[2], b[3]); return w; }
__device__ __forceinline__ f32x4 unpk_lo(u32x4 w) { return (f32x4){__uint_as_float(w.x << 16), __uint_as_float(w.x & 0xffff0000u), __uint_as_float(w.y << 16), __uint_as_float(w.y & 0xffff0000u)}; }
__device__ __forceinline__ f32x4 unpk_hi(u32x4 w) { return (f32x4){__uint_as_float(w.z << 16), __uint_as_float(w.z & 0xffff0000u), __uint_as_float(w.w << 16), __uint_as_float(w.w & 0xffff0000u)}; }

#ifndef EPI_NT
#define EPI_NT 0
#endif
__device__ __forceinline__ void st16(bf16_t* p, u32x4 v) { if (EPI_NT) __builtin_nontemporal_store(v, (u32x4*)p); else *(u32x4*)p = v; }
__device__ __forceinline__ float row16_sum(float v) {
    v += __builtin_bit_cast(float, __builtin_amdgcn_update_dpp(0, __builtin_bit_cast(int, v), 0x128, 0xf, 0xf, false));
    v += __builtin_bit_cast(float, __builtin_amdgcn_update_dpp(0, __builtin_bit_cast(int, v), 0x124, 0xf, 0xf, false));
    v += __builtin_bit_cast(float, __builtin_amdgcn_update_dpp(0, __builtin_bit_cast(int, v), 0x122, 0xf, 0xf, false));
    v += __builtin_bit_cast(float, __builtin_amdgcn_update_dpp(0, __builtin_bit_cast(int, v), 0x121, 0xf, 0xf, false));
    return v;
}
struct EpiPlain {
    static constexpr bool PERM = true, AFTER_DRAIN = false;
    bf16_t* O; int ldc;
    __device__ __forceinline__ void operator()(const f32x4 (&acc)[2][2][4][2], const Unit& u, int wr, int wc, int fr, int fq) const {
        const int row0 = u.pm * BM + wr * 64 + fr, col0 = u.pn * BM + wc * 32 + 8 * fq;
#pragma unroll
        for (int ai = 0; ai < 2; ++ai)
#pragma unroll
            for (int m = 0; m < 4; ++m) { bf16_t* rowp = O + (size_t)(row0 + ai * HALF + m * 16) * ldc + col0;
#pragma unroll
                for (int bj = 0; bj < 2; ++bj) st16(rowp + bj * HALF, pack8(acc[ai][bj][m][0], acc[ai][bj][m][1])); }
    }
};
struct EpiUZ {
    static constexpr bool PERM = true, AFTER_DRAIN = false;
    bf16_t* O; int ldc;
    __device__ __forceinline__ void operator()(const f32x4 (&acc)[2][2][4][2], const Unit& u, int wr, int wc, int fr, int fq) const {
        const int row0 = u.pm * BM + wr * 64 + fr, ch0 = u.pn * HALF + wc * 32 + 8 * fq;
#pragma unroll
        for (int ai = 0; ai < 2; ++ai)
#pragma unroll
            for (int m = 0; m < 4; ++m) { bf16_t* rowp = O + (size_t)(row0 + ai * HALF + m * 16) * ldc + ch0;
                const f32x4 g0 = gelu4(acc[ai][0][m][0]), g1 = gelu4(acc[ai][0][m][1]), s0 = silu4(acc[ai][1][m][0]), s1 = silu4(acc[ai][1][m][1]);
                st16(rowp, pack8(g0 * s0, g1 * s1)); }
    }
};
struct EpiGvT {
    static constexpr bool PERM = true, AFTER_DRAIN = false;
    bf16_t* O; int ldc; float* ST; int ntok;
    __device__ __forceinline__ void operator()(const f32x4 (&acc)[2][2][4][2], const Unit& u, int wr, int wc, int fr, int fq) const {
        const int ch0 = u.pm * BM + wr * 64 + fr, tok0 = u.pn * BM + wc * 32 + 8 * fq;
        f32x4 s1[2][2], s2[2][2];
#pragma unroll
        for (int bj = 0; bj < 2; ++bj)
#pragma unroll
            for (int n = 0; n < 2; ++n) { s1[bj][n] = (f32x4){0.f, 0.f, 0.f, 0.f}; s2[bj][n] = (f32x4){0.f, 0.f, 0.f, 0.f}; }
#pragma unroll
        for (int ai = 0; ai < 2; ++ai)
#pragma unroll
            for (int m = 0; m < 4; ++m) { bf16_t* rowp = O + (size_t)(ch0 + ai * HALF + m * 16) * ldc + tok0;
#pragma unroll
                for (int bj = 0; bj < 2; ++bj) { const f32x4 v0 = gelu4(acc[ai][bj][m][0]), v1 = gelu4(acc[ai][bj][m][1]);
                    s1[bj][0] += v0; s2[bj][0] += v0 * v0; s1[bj][1] += v1; s2[bj][1] += v1 * v1;
                    st16(rowp + bj * HALF, pack8(v0, v1)); } }
#pragma unroll
        for (int bj = 0; bj < 2; ++bj)
#pragma unroll
            for (int n = 0; n < 2; ++n)
#pragma unroll
                for (int e = 0; e < 4; ++e) { s1[bj][n][e] = row16_sum(s1[bj][n][e]); s2[bj][n][e] = row16_sum(s2[bj][n][e]); }
        if (fr == 0) { float* st = ST + ((size_t)(u.pm * 2 + wr) * ntok + tok0) * 2;
#pragma unroll
            for (int bj = 0; bj < 2; ++bj)
#pragma unroll
                for (int n = 0; n < 2; ++n) { float* q = st + (bj * HALF + 4 * n) * 2;
                    *(f32x4*)q = (f32x4){s1[bj][n][0], s2[bj][n][0], s1[bj][n][1], s2[bj][n][1]};
                    *(f32x4*)(q + 4) = (f32x4){s1[bj][n][2], s2[bj][n][2], s1[bj][n][3], s2[bj][n][3]}; } }
    }
};
struct EpiPZ {
    static constexpr bool PERM = true, AFTER_DRAIN = false;
    bf16_t* P; bf16_t* SZ; int ldc; int nP;
    __device__ __forceinline__ void operator()(const f32x4 (&acc)[2][2][4][2], const Unit& u, int wr, int wc, int fr, int fq) const {
        const bool isz = u.pn >= nP; bf16_t* base = isz ? SZ : P;
        const int row0 = u.pm * BM + wr * 64 + fr, col0 = (isz ? u.pn - nP : u.pn) * BM + wc * 32 + 8 * fq;
#pragma unroll
        for (int ai = 0; ai < 2; ++ai)
#pragma unroll
            for (int m = 0; m < 4; ++m) { bf16_t* rowp = base + (size_t)(row0 + ai * HALF + m * 16) * ldc + col0;
#pragma unroll
                for (int bj = 0; bj < 2; ++bj) { f32x4 v0 = acc[ai][bj][m][0], v1 = acc[ai][bj][m][1];
                    if (isz) { v0 = silu4(v0); v1 = silu4(v1); }
                    st16(rowp + bj * HALF, pack8(v0, v1)); } }
    }
};
struct EpiMix {
    static constexpr bool PERM = true, AFTER_DRAIN = false;
    const bf16_t* SZ; bf16_t* Y; int ldc; const float* bgrp; const float* scale;
    __device__ __forceinline__ void operator()(const f32x4 (&acc)[2][2][4][2], const Unit& u, int wr, int wc, int fr, int fq) const {
        const int row0 = u.pm * BM + wr * 64 + fr, ch0 = u.pn * BM + wc * 32 + 8 * fq;
        f32x4 sc[2][2], bs[2][2];
#pragma unroll
        for (int bj = 0; bj < 2; ++bj)
#pragma unroll
            for (int n = 0; n < 2; ++n) { sc[bj][n] = *(const f32x4*)(scale + ch0 + bj * HALF + 4 * n); bs[bj][n] = *(const f32x4*)(bgrp + ch0 + bj * HALF + 4 * n) * sc[bj][n]; }
#pragma unroll
        for (int ai = 0; ai < 2; ++ai) {
            u32x4 z[4][2];
#pragma unroll
            for (int m = 0; m < 4; ++m)
#pragma unroll
                for (int bj = 0; bj < 2; ++bj) z[m][bj] = *(const u32x4*)(SZ + (size_t)(row0 + ai * HALF + m * 16) * ldc + ch0 + bj * HALF);
#pragma unroll
            for (int m = 0; m < 4; ++m) { const size_t off = (size_t)(row0 + ai * HALF + m * 16) * ldc + ch0;
#pragma unroll
                for (int bj = 0; bj < 2; ++bj) {
                    const f32x4 v0 = (acc[ai][bj][m][0] * sc[bj][0] + bs[bj][0]) * unpk_lo(z[m][bj]), v1 = (acc[ai][bj][m][1] * sc[bj][1] + bs[bj][1]) * unpk_hi(z[m][bj]);
                    st16(Y + off + bj * HALF, pack8(v0, v1)); } } }
    }
};

template <class Epi, class Sched, bool ALIGN_EPI = false, bool SP2 = false, bool PROBE = false>
__device__ __forceinline__ void gemm_phase(PG8_LAS unsigned char* lds, const Gemm g, const Sched& S, const Epi& E) {
#define PG8_PSTAMP(k) do { if (PROBE && blockIdx.x == 0 && threadIdx.x == 0) ((PG8_LAS unsigned long long*)(lds + STAGE_BYTES + 1024))[k] = __builtin_amdgcn_s_memtime(); } while (0)
    const int tid = threadIdx.x, wid = __builtin_amdgcn_readfirstlane(tid >> 6), lane = tid & 63, wr = wid >> 2, wc = wid & 3, fr = lane & 15, fq = lane >> 4;
    const int K = g.K, nt = K / BK;
    unsigned voffA[2], voffB[2];
#pragma unroll
    for (int i = 0; i < 2; ++i) { int R, C; stage_rc(tid * 16 + i * 8192, R, C); const int Rb = Epi::PERM ? ((R & ~31) + perm32(R & 31)) : R;
        voffA[i] = (unsigned)(R * g.lda + C) * 2u; voffB[i] = (unsigned)(Rb * g.ldb + C) * 2u; }
    const size_t kstep = (size_t)(BK * 2);
    const size_t hstepA = (size_t)HALF * g.lda * 2, hstepB = (size_t)HALF * g.ldb * 2;
    const size_t tstepA = 2 * hstepA, tstepB = 2 * hstepB;
    const unsigned ldsw = (unsigned)wid * 1024u;
    const int aoff = lds_byte(wr * 64 + fr, fq * 8), boff = lds_byte(wc * 32 + fr, fq * 8);
#define PG8_SA(b, h) (((b) * 2 + (h)) * HTB)
#define PG8_SB(b, h) ((4 + (b) * 2 + (h)) * HTB)
#define PG8_STAGE(bufoff, gbase, voff) do { _Pragma("unroll") for (int _i = 0; _i < 2; ++_i) \
        __builtin_amdgcn_global_load_lds((const unsigned*)((const char*)(gbase) + (voff)[_i]), (PG8_LAS unsigned*)(lds + (bufoff) + ldsw + _i * 8192), 16, 0, 0); } while (0)
#define PG8_LDA(dst, b, h) do { _Pragma("unroll") for (int m = 0; m < 4; ++m) _Pragma("unroll") for (int k = 0; k < 2; ++k) dst[m][k] = *(const PG8_LAS bf16x8*)(lds + PG8_SA(b, h) + aoff + m * 2048 + k * 1024); } while (0)
#define PG8_LDB(dst, b, h) do { _Pragma("unroll") for (int n = 0; n < 2; ++n) _Pragma("unroll") for (int k = 0; k < 2; ++k) dst[n][k] = *(const PG8_LAS bf16x8*)(lds + PG8_SB(b, h) + boff + n * 2048 + k * 1024); } while (0)
#define PG8_MMA(ai, bj, At, Bt) do { if (GSETPRIO) __builtin_amdgcn_s_setprio(1); _Pragma("unroll") for (int m = 0; m < 4; ++m) _Pragma("unroll") for (int n = 0; n < 2; ++n) _Pragma("unroll") for (int k = 0; k < 2; ++k) \
        acc[ai][bj][m][n] = __builtin_amdgcn_mfma_f32_16x16x32_bf16(Bt[n][k], At[m][k], acc[ai][bj][m][n], 0, 0, 0); if (GSETPRIO) __builtin_amdgcn_s_setprio(0); } while (0)
#define PG8_WAIT_V(n) asm volatile("s_waitcnt vmcnt(" #n ")" ::: "memory")
#define PG8_WAIT_L(n) asm volatile("s_waitcnt lgkmcnt(" #n ")" ::: "memory")
#define PG8_BAR __builtin_amdgcn_s_barrier()
#define PG8_SCHED __builtin_amdgcn_sched_barrier(0)
    Unit cur, nxt; int ui = 0;
    if (!S.next(0, cur)) return;
    f32x4 acc[2][2][4][2];
#pragma unroll
    for (int a = 0; a < 2; ++a)
#pragma unroll
        for (int b = 0; b < 2; ++b)
#pragma unroll
            for (int m = 0; m < 4; ++m)
#pragma unroll
                for (int n = 0; n < 2; ++n) acc[a][b][m][n] = (f32x4){0.f, 0.f, 0.f, 0.f};
    bf16x8 At[4][2], B0[2][2], B1[2][2];
    const char* cA = (const char*)g.A + (size_t)cur.pm * tstepA + g.acol(cur.pn); const char* cB = (const char*)g.Bt + (size_t)cur.pn * tstepB + g.bcol(cur.pm);
    S.a_ready(cur);
    if constexpr (SP2) {
        PG8_STAGE(PG8_SB(0, 0), cB, voffB); PG8_STAGE(PG8_SB(0, 1), cB + hstepB, voffB); PG8_STAGE(PG8_SA(0, 0), cA, voffA); PG8_STAGE(PG8_SA(0, 1), cA + hstepA, voffA);
        if (wr == 1) PG8_BAR;
        PG8_WAIT_V(2); PG8_BAR;
        PG8_STAGE(PG8_SB(1, 0), cB + kstep, voffB); PG8_STAGE(PG8_SA(1, 0), cA + kstep, voffA); PG8_STAGE(PG8_SB(1, 1), cB + hstepB + kstep, voffB);
        PG8_WAIT_V(6); PG8_BAR;
    } else {
        PG8_STAGE(PG8_SB(0, 0), cB, voffB); PG8_STAGE(PG8_SA(0, 0), cA, voffA); PG8_STAGE(PG8_SB(0, 1), cB + hstepB, voffB); PG8_STAGE(PG8_SA(0, 1), cA + hstepA, voffA);
        if (wr == 1) PG8_BAR;
        PG8_WAIT_V(4); PG8_BAR;
        PG8_STAGE(PG8_SB(1, 0), cB + kstep, voffB); PG8_STAGE(PG8_SA(1, 0), cA + kstep, voffA); PG8_STAGE(PG8_SB(1, 1), cB + hstepB + kstep, voffB);
        PG8_WAIT_V(6); PG8_BAR;
    }
    for (;;) {
        const bool has_next = S.next(ui + 1, nxt);
        const char* nA = has_next ? (const char*)g.A + (size_t)nxt.pm * tstepA + g.acol(nxt.pn) : cA; const char* nB = has_next ? (const char*)g.Bt + (size_t)nxt.pn * tstepB + g.bcol(nxt.pm) : cB;
        for (int t = 0; t < nt; t += 2) {
            const bool last = (t == nt - 2);
            const char* a1 = cA + (size_t)(t + 1) * kstep;
            const char* a2 = last ? nA : cA + (size_t)(t + 2) * kstep; const char* b2 = last ? nB : cB + (size_t)(t + 2) * kstep;
            const char* a3 = a2 + kstep; const char* b3 = b2 + kstep;
            if (last && has_next) S.a_ready(nxt);
            if constexpr (SP2) {
            PG8_LDB(B0, 0, 0); PG8_LDB(B1, 0, 1); PG8_SCHED; PG8_LDA(At, 0, 0); PG8_STAGE(PG8_SA(1, 1), a1 + hstepA, voffA);
            PG8_WAIT_V(8); PG8_WAIT_L(0); PG8_BAR; if (PROBE && t == 0 && ui == 2) PG8_PSTAMP(2); PG8_MMA(0, 0, At, B0); PG8_MMA(0, 1, At, B1); PG8_BAR; PG8_SCHED;
            PG8_LDA(At, 0, 1); PG8_STAGE(PG8_SB(0, 0), b2, voffB); PG8_STAGE(PG8_SB(0, 1), b2 + hstepB, voffB); PG8_STAGE(PG8_SA(0, 0), a2, voffA);
            PG8_WAIT_V(8); PG8_WAIT_L(0); PG8_BAR; PG8_MMA(1, 0, At, B0); PG8_MMA(1, 1, At, B1); PG8_BAR; PG8_SCHED;
            PG8_LDB(B0, 1, 0); PG8_LDB(B1, 1, 1); PG8_SCHED; PG8_LDA(At, 1, 0); PG8_STAGE(PG8_SA(0, 1), a2 + hstepA, voffA);
            PG8_WAIT_V(8); PG8_WAIT_L(0); PG8_BAR; PG8_MMA(0, 0, At, B0); PG8_MMA(0, 1, At, B1); PG8_BAR; PG8_SCHED;
            PG8_LDA(At, 1, 1); PG8_STAGE(PG8_SB(1, 0), b3, voffB); PG8_STAGE(PG8_SB(1, 1), b3 + hstepB, voffB); PG8_STAGE(PG8_SA(1, 0), a3, voffA);
            PG8_WAIT_V(8); PG8_WAIT_L(0); PG8_BAR; PG8_MMA(1, 0, At, B0); PG8_MMA(1, 1, At, B1); PG8_BAR; PG8_SCHED;
            } else {
            PG8_LDB(B0, 0, 0); PG8_SCHED; PG8_LDA(At, 0, 0); PG8_STAGE(PG8_SA(1, 1), a1 + hstepA, voffA);
            PG8_WAIT_L(8); PG8_BAR; PG8_WAIT_L(0); PG8_MMA(0, 0, At, B0); PG8_BAR; PG8_SCHED;
            PG8_LDB(B1, 0, 1); PG8_STAGE(PG8_SB(0, 0), b2, voffB);
            PG8_BAR; PG8_WAIT_L(0); PG8_MMA(0, 1, At, B1); PG8_BAR;
            PG8_LDA(At, 0, 1); PG8_STAGE(PG8_SA(0, 0), a2, voffA);
            PG8_BAR; PG8_WAIT_L(0); PG8_MMA(1, 0, At, B0); PG8_BAR; PG8_SCHED;
            PG8_STAGE(PG8_SB(0, 1), b2 + hstepB, voffB);
            PG8_WAIT_V(6); PG8_BAR; PG8_MMA(1, 1, At, B1); PG8_BAR;
            PG8_LDB(B0, 1, 0); PG8_SCHED; PG8_LDA(At, 1, 0); PG8_STAGE(PG8_SA(0, 1), a2 + hstepA, voffA);
            PG8_WAIT_L(8); PG8_BAR; PG8_WAIT_L(0); PG8_MMA(0, 0, At, B0); PG8_BAR; PG8_SCHED;
            PG8_LDB(B1, 1, 1); PG8_STAGE(PG8_SB(1, 0), b3, voffB);
            PG8_BAR; PG8_WAIT_L(0); PG8_MMA(0, 1, At, B1); PG8_BAR;
            PG8_LDA(At, 1, 1); PG8_STAGE(PG8_SA(1, 0), a3, voffA);
            PG8_BAR; PG8_WAIT_L(0); PG8_MMA(1, 0, At, B0); PG8_BAR; PG8_SCHED;
            PG8_STAGE(PG8_SB(1, 1), b3 + hstepB, voffB);
            PG8_WAIT_V(6); PG8_BAR; PG8_MMA(1, 1, At, B1); PG8_BAR;
            }
        }
        if (PROBE && ui == 1) PG8_PSTAMP(0); if (PROBE && ui == 2) PG8_PSTAMP(3);
        if constexpr (ALIGN_EPI) { if (wr == 0) PG8_BAR; }
        if constexpr (!Epi::AFTER_DRAIN) { E(acc, cur, wr, wc, fr, fq); S.done(cur); }
        if (PROBE && ui == 1) PG8_PSTAMP(1); if (PROBE && ui == 2) PG8_PSTAMP(4);
        if (!has_next) break;
#pragma unroll
        for (int a = 0; a < 2; ++a)
#pragma unroll
            for (int b = 0; b < 2; ++b)
#pragma unroll
                for (int m = 0; m < 4; ++m)
#pragma unroll
                    for (int n = 0; n < 2; ++n) acc[a][b][m][n] = (f32x4){0.f, 0.f, 0.f, 0.f};
        cur = nxt; cA = nA; cB = nB; ++ui;
        if constexpr (ALIGN_EPI) { if (wr == 1) PG8_BAR; }
    }
    PG8_WAIT_V(0);
    if constexpr (!ALIGN_EPI) { if (wr == 0) PG8_BAR; }
    PG8_BAR;
    if constexpr (Epi::AFTER_DRAIN) { E.fused(acc, cur, wr, wc, fr, fq, lds, wid, lane); S.done(cur); }
#undef PG8_PSTAMP
#undef PG8_SA
#undef PG8_SB
#undef PG8_STAGE
#undef PG8_LDA
#undef PG8_LDB
#undef PG8_MMA
#undef PG8_WAIT_V
#undef PG8_WAIT_L
#undef PG8_BAR
#undef PG8_SCHED
}
}

constexpr int NWAVES = 8;
constexpr int DM = 4096, EI = 8192, BATCH = 4, SEQ = 2048, MTOK = BATCH * SEQ;
constexpr int CHUNK = 128, NHEAD = 16, HDIM = EI / NHEAD;
constexpr int NGRP = 4, GWID = EI / NGRP;
constexpr float EPS = 1e-6f;
constexpr int NST = 64;
constexpr int NPH = 10;
static_assert(MTOK % 256 == 0 && SEQ % CHUNK == 0 && SEQ % 256 == 0, "tiling");

constexpr size_t MiB = 1u << 20;
constexpr size_t WS_CTL = 0, CTL_ZERO_BYTES = 64 * 1024;
constexpr size_t WS_W1UZ = 1 * MiB;
constexpr size_t WS_W1V  = WS_W1UZ + (size_t)2 * EI * DM * 2;
constexpr size_t WS_W2   = WS_W1V + (size_t)EI * DM * 2;
constexpr size_t WS_W3   = WS_W2 + (size_t)DM * EI * 2;
constexpr size_t WS_W4   = WS_W3 + (size_t)2 * EI * DM * 2;
constexpr size_t WS_W5   = WS_W4 + (size_t)EI * GWID * 2;
constexpr size_t WS_H    = WS_W5 + (size_t)DM * EI * 2;
constexpr size_t WS_B0   = WS_H + (size_t)MTOK * DM * 2;
constexpr size_t WS_B1   = WS_B0 + (size_t)MTOK * EI * 2;
constexpr size_t WS_B2   = WS_B1 + (size_t)MTOK * EI * 2;
constexpr size_t WS_M    = WS_B2 + (size_t)MTOK * EI * 2;
constexpr size_t WS_ST   = WS_M + (size_t)MTOK * DM * 2;
constexpr size_t WS_DBG  = WS_ST + (size_t)NST * MTOK * 8;
constexpr size_t WS_X1B  = WS_DBG + (size_t)MTOK * 8;
constexpr size_t WS_END  = WS_X1B + (size_t)MTOK * DM * 2;
constexpr size_t WS_W3P = WS_W3 + (size_t)EI * DM * 2;
constexpr size_t WS_WC = WS_W1V, WS_Y1 = WS_W1UZ, WS_PH = WS_B1;
static_assert(WS_B2 == WS_B1 + (size_t)MTOK * EI * 2 && (size_t)NGRP * MTOK * DM * 2 <= 2 * (size_t)MTOK * EI * 2, "PH overlays B1|B2");
constexpr int CW_BAR = 4096;

constexpr int RING_OFF = 0, RING_BYTES = 131072;
constexpr int LDSCTL_OFF = RING_BYTES, MISC_OFF = LDSCTL_OFF + 320;
constexpr int LDS_BYTES = 147456;
static_assert(MISC_OFF + 128 <= LDS_BYTES, "LDS map");

#define GAS __attribute__((address_space(1)))
#define LAS __attribute__((address_space(3)))
typedef unsigned short bf16;
typedef unsigned v4u __attribute__((ext_vector_type(4)));
typedef float f32x4 __attribute__((ext_vector_type(4)));
typedef short bf16x8 __attribute__((ext_vector_type(8)));
typedef GAS unsigned gu32;
typedef GAS unsigned long long gu64;
#define RLX_AGENT __ATOMIC_RELAXED, __HIP_MEMORY_SCOPE_AGENT
#define LDS_WAIT() asm volatile("s_waitcnt lgkmcnt(0)" ::: "memory")
#define VM_WAIT() asm volatile("s_waitcnt vmcnt(0)" ::: "memory")
__device__ __forceinline__ unsigned long long rt() { return __builtin_amdgcn_s_memrealtime(); }
__device__ __forceinline__ unsigned f2bf(float f) { unsigned u = __builtin_bit_cast(unsigned, f); return (u + 0x7fffu + ((u >> 16) & 1u)) >> 16; }
__device__ __forceinline__ unsigned pk2(float lo, float hi) { return f2bf(lo) | (f2bf(hi) << 16); }

#define XB_TMO      128
#define XB_XCNT(j)  (256  + 64 * (j))
#define XB_XSUB(j)  (1280 + 64 * (j))
#define XB_XGEN(j)  (2304 + 64 * (j))
#define XB_TOP      3328
#define XB_TOPGEN   3392
#define XCD_BAR_WORDS 3456
#define XB_SPIN_CAP (1u << 18)

__device__ __forceinline__ unsigned xb_ld(unsigned* p)              { return __hip_atomic_load(p, __ATOMIC_RELAXED, __HIP_MEMORY_SCOPE_AGENT); }
__device__ __forceinline__ unsigned xb_add(unsigned* p, unsigned v) { return __hip_atomic_fetch_add(p, v, __ATOMIC_RELAXED, __HIP_MEMORY_SCOPE_AGENT); }
__device__ __forceinline__ unsigned xb_xcc_id() { return (unsigned)__builtin_amdgcn_s_getreg((3 << 11) | 20) & 0xFu; }
#define XB_SPIN(cond, bar) do { unsigned _sp = 0; while (cond) { __builtin_amdgcn_s_sleep(1); \
    if ((++_sp & 255u) == 0u) { if (xb_ld(&(bar)[XB_TMO])) break; if (_sp > XB_SPIN_CAP) { atomicAdd(&(bar)[XB_TMO], 1u); break; } } } } while (0)

struct XcdBarrier {
    unsigned* bar; unsigned x;
    volatile LAS unsigned* st;
};

__device__ __forceinline__ XcdBarrier xcd_barrier_post(unsigned* bar, volatile LAS unsigned* st) {
    XcdBarrier b; b.bar = bar; b.x = xb_xcc_id(); b.st = st;
    if (threadIdx.x == 0) (void)xb_add(&bar[XB_XCNT(b.x)], 1u);
    return b;
}
__device__ __forceinline__ void xcd_barrier_complete(unsigned* bar, unsigned x, unsigned& nloc, unsigned& nx) {
    const unsigned G = gridDim.x * gridDim.y * gridDim.z;
    unsigned sum, cnt, mine, sp = 0u;
    for (;;) {
        sum = 0u; cnt = 0u; mine = 0u;
#pragma unroll
        for (unsigned j = 0; j < 16; ++j) { const unsigned c = xb_ld(&bar[XB_XCNT(j)]); sum += c; cnt += (c > 0u) ? 1u : 0u; mine = (j == x) ? c : mine; }
        if (sum == G) break;
        __builtin_amdgcn_s_sleep(1);
        if ((++sp & 255u) == 0u) { if (xb_ld(&bar[XB_TMO])) break; if (sp > XB_SPIN_CAP) { atomicAdd(&bar[XB_TMO], 1u); break; } }
    }
    nloc = mine > 0u ? mine : 1u; nx = cnt > 0u ? cnt : 1u;
}

__device__ __forceinline__ void xcd_barrier(const XcdBarrier& b) {
    asm volatile("s_waitcnt vmcnt(0)" ::: "memory");
    __syncthreads();
    if (threadIdx.x == 0) {
        unsigned* bar = b.bar;
        __builtin_amdgcn_s_waitcnt(0);
        unsigned nloc = b.st[0], nx = b.st[1];
        if (nloc == 0u) { xcd_barrier_complete(bar, b.x, nloc, nx); b.st[0] = nloc; b.st[1] = nx; }
        const unsigned old = xb_add(&bar[XB_XSUB(b.x)], 1u);
        const unsigned gen = old / nloc;
        if (old + 1u == (gen + 1u) * nloc) {
            __builtin_amdgcn_fence(__ATOMIC_RELEASE, "agent");
            asm volatile("s_waitcnt vmcnt(0)" ::: "memory");
            const unsigned og = xb_add(&bar[XB_TOP], 1u);
            const unsigned tg = og / nx;
            if (og + 1u == (tg + 1u) * nx) xb_add(&bar[XB_TOPGEN], 1u);
            else XB_SPIN(xb_ld(&bar[XB_TOPGEN]) == tg, bar);
            __builtin_amdgcn_fence(__ATOMIC_ACQUIRE, "agent");
            xb_add(&bar[XB_XGEN(b.x)], 1u);
            asm volatile("s_waitcnt vmcnt(0)" ::: "memory");
        } else {
            XB_SPIN(xb_ld(&bar[XB_XGEN(b.x)]) == gen, bar);
            __builtin_amdgcn_fence(__ATOMIC_ACQUIRE, "agent");
            asm volatile("s_waitcnt vmcnt(0)" ::: "memory");
        }
    }
    __syncthreads();
}

enum { IN_X = 0, IN_PRE, IN_POST, IN_AWIN, IN_ALNG, IN_ALNB, IN_AWS, IN_ABS, IN_AWOUT, IN_BWIN, IN_BWGRP, IN_BBGRP, IN_BSCALE, IN_BWOUT, N_IN };
struct Args { const float* in[N_IN]; float* out; unsigned char* ws; int ph_lo, ph_hi; };
struct Frame {
    LAS unsigned char* lds;
    volatile LAS unsigned* MISC;
    gu32* ctl;
    int tid, lane, wave;
    int vcu, G;
};
__device__ __forceinline__ float wave_sum(float v) {
#pragma unroll
    for (int o = 1; o < 64; o <<= 1) v += __shfl_xor(v, o);
    return v;
}
__device__ __forceinline__ float dot4(f32x4 a, f32x4 b) { return (a.x * b.x + a.y * b.y) + (a.z * b.z + a.w * b.w); }
using pg8::cvt_pk_bf16; using pg8::pack8; using pg8::unpk_lo; using pg8::unpk_hi; using pg8::u32x4; using pg8::f32x2;

struct CvDesc { const float* src; bf16* dst; int ldw, K, plain; };
__device__ __forceinline__ CvDesc cv_make(const float* W, int ldw, int K, int n0, bf16* WT, int drow0, int k0, int lane) {
    const int kq = lane & 7, nq = lane >> 3; CvDesc d; d.src = W + (size_t)(k0 + 8 * kq) * ldw + n0 + 4 * nq; d.dst = WT + (size_t)(drow0 + 4 * nq) * K + k0 + 8 * kq; d.ldw = ldw; d.K = K; d.plain = 0; return d; }
__device__ __forceinline__ CvDesc cv_make_plain(const float* W, int ldw, bf16* D, int ldd, int row0, int col0, int lane) {
    CvDesc d; d.src = W + (size_t)row0 * ldw + col0 + 8 * lane; d.dst = D + (size_t)row0 * ldd + col0 + 8 * lane; d.ldw = ldw; d.K = ldd; d.plain = 1; return d; }
__device__ __forceinline__ void cv_load(const CvDesc& d, f32x4 (&r)[8]) {
    const GAS f32x4* src = (const GAS f32x4*)d.src;
    if (d.plain) {
#pragma unroll
        for (int j = 0; j < 4; ++j) { r[2 * j] = __builtin_nontemporal_load(src + (size_t)j * (d.ldw / 4)); r[2 * j + 1] = __builtin_nontemporal_load(src + (size_t)j * (d.ldw / 4) + 1); }
    } else {
#pragma unroll
        for (int j = 0; j < 8; ++j) r[j] = __builtin_nontemporal_load(src + (size_t)j * (d.ldw / 4));
    }
}
__device__ __forceinline__ unsigned wq(unsigned w) { if (WDROP == 0) return w; constexpr unsigned h = (1u << (WDROP > 0 ? WDROP - 1 : 0)) * 0x00010001u, m = ~(((1u << WDROP) - 1u) * 0x00010001u); return (w + h) & m; }
__device__ __forceinline__ v4u wq4(v4u o) { o.x = wq(o.x); o.y = wq(o.y); o.z = wq(o.z); o.w = wq(o.w); return o; }
__device__ __forceinline__ void cv_store(const CvDesc& d, const f32x4 (&r)[8]) {
    if (d.plain) {
#pragma unroll
        for (int j = 0; j < 4; ++j) __builtin_nontemporal_store(wq4(pack8(r[2 * j], r[2 * j + 1])), (GAS v4u*)(d.dst + (size_t)j * d.K));
    } else {
#pragma unroll
        for (int e = 0; e < 4; ++e) { v4u o; o.x = cvt_pk_bf16(r[0][e], r[1][e]); o.y = cvt_pk_bf16(r[2][e], r[3][e]); o.z = cvt_pk_bf16(r[4][e], r[5][e]); o.w = cvt_pk_bf16(r[6][e], r[7][e]);
            __builtin_nontemporal_store(wq4(o), (GAS v4u*)(d.dst + (size_t)e * d.K)); }
    }
}
__device__ __forceinline__ void rms_row_to_bf16(const float* xrow, const float* g, bf16* orow, int lane) {
    const GAS f32x4* xr = (const GAS f32x4*)xrow + lane;
    f32x4 v[16]; float s = 0.f;
#pragma unroll
    for (int j = 0; j < 16; ++j) { v[j] = xr[64 * j]; s += dot4(v[j], v[j]); }
    const float rstd = 1.f / sqrtf(wave_sum(s) * (1.f / DM) + EPS);
    const GAS f32x4* gr = (const GAS f32x4*)g + lane;
    GAS unsigned long long* o8 = (GAS unsigned long long*)orow + lane;
#pragma unroll
    for (int j = 0; j < 16; ++j) { const f32x4 o = v[j] * rstd * gr[64 * j];
        o8[64 * j] = (unsigned long long)cvt_pk_bf16(o.x, o.y) | ((unsigned long long)cvt_pk_bf16(o.z, o.w) << 32); }
}
constexpr int CI0 = (DM / 64) * (2 * EI / 32), CI1 = (DM / 64) * (EI / 32), CI2 = (EI / 64) * (DM / 32), CI3 = (DM / 64) * (2 * EI / 32)  , CI4G = (GWID / 64) * (GWID / 32), CI4 = NGRP * CI4G, CI5 = CI2;
constexpr int CSET_A = 0, CNT_A = CI0 + CI1, CSET_B = CNT_A, CNT_B = CI2 + CI3, CSET_C = CSET_B + CNT_B, CNT_C = CI4 + CI5;
__device__ __forceinline__ CvDesc conv_desc(const Args& a, int it, int lane) {
    int r = it;
    if (r < CI0) { constexpr int nbk = 2 * EI / 32; const int kb = r / nbk, nb = r % nbk, t = nb >> 3, jb = nb & 7;
        const int n0 = (jb < 4) ? 128 * t + 32 * jb : 2 * EI + 128 * t + 32 * (jb - 4);
        return cv_make(a.in[IN_AWIN], 3 * EI, DM, n0, (bf16*)(a.ws + WS_W1UZ), 32 * nb, 64 * kb, lane); } r -= CI0;
    if (r < CI1) { constexpr int nbk = EI / 32; const int kb = r / nbk, nb = r % nbk;
        return cv_make(a.in[IN_AWIN], 3 * EI, DM, EI + 32 * nb, (bf16*)(a.ws + WS_W1V), 32 * nb, 64 * kb, lane); } r -= CI1;
    if (r < CI2) { constexpr int nbk = DM / 32; const int kb = r / nbk, nb = r % nbk;
        return cv_make(a.in[IN_AWOUT], DM, EI, 32 * nb, (bf16*)(a.ws + WS_W2), 32 * nb, 64 * kb, lane); } r -= CI2;
#if WCOMB
    if (r < CI3 / 2) { constexpr int nbk = EI / 32; const int kb = r / nbk, nb = r % nbk;
        return cv_make(a.in[IN_BWIN], 2 * EI, DM, EI + 32 * nb, (bf16*)(a.ws + WS_W3), 32 * nb, 64 * kb, lane); }
    if (r < CI3) { r -= CI3 / 2; constexpr int nseg = EI / 512; const int rq = r / nseg, sg = r % nseg;
        return cv_make_plain(a.in[IN_BWIN], 2 * EI, (bf16*)(a.ws + WS_W3P), EI, 4 * rq, 512 * sg, lane); } r -= CI3;
#else
    if (r < CI3) { constexpr int nbk = 2 * EI / 32; const int kb = r / nbk, nb = r % nbk;
        return cv_make(a.in[IN_BWIN], 2 * EI, DM, 32 * nb, (bf16*)(a.ws + WS_W3), 32 * nb, 64 * kb, lane); } r -= CI3;
#endif
    if (r < CI4) { constexpr int nbk = GWID / 32; const int g = r / CI4G; r -= g * CI4G; const int kb = r / nbk, nb = r % nbk;
        return cv_make(a.in[IN_BWGRP] + (size_t)g * GWID * GWID, GWID, GWID, 32 * nb, (bf16*)(a.ws + WS_W4) + (size_t)g * GWID * GWID, 32 * nb, 64 * kb, lane); } r -= CI4;
    { constexpr int nbk = DM / 32; const int kb = r / nbk, nb = r % nbk;
        return cv_make(a.in[IN_BWOUT], DM, EI, 32 * nb, (bf16*)(a.ws + WS_W5), 32 * nb, 64 * kb, lane); }
}
__device__ __forceinline__ void conv_rounds(const Args& a, Frame& F, int base, int count, int i_lo, int i_hi, bool rev = false) {
    const int gw = F.vcu * NWAVES + F.wave, NGW = F.G * NWAVES;
    int i = i_lo;
    if (i + 1 < i_hi && gw + (i + 1) * NGW < count) {
        CvDesc d0 = conv_desc(a, base + (rev ? count - 1 - (gw + i * NGW) : gw + i * NGW), F.lane), d1 = conv_desc(a, base + (rev ? count - 1 - (gw + (i + 1) * NGW) : gw + (i + 1) * NGW), F.lane);
        f32x4 r0[8], r1[8]; cv_load(d0, r0); cv_load(d1, r1); i += 2;
        for (; i + 1 < i_hi && gw + (i + 1) * NGW < count; i += 2) {
            const CvDesc e0 = conv_desc(a, base + (rev ? count - 1 - (gw + i * NGW) : gw + i * NGW), F.lane), e1 = conv_desc(a, base + (rev ? count - 1 - (gw + (i + 1) * NGW) : gw + (i + 1) * NGW), F.lane);
            f32x4 q0[8], q1[8]; cv_load(e0, q0); cv_load(e1, q1);
            cv_store(d0, r0); cv_store(d1, r1);
            d0 = e0; d1 = e1;
#pragma unroll
            for (int j = 0; j < 8; ++j) { r0[j] = q0[j]; r1[j] = q1[j]; }
        }
        cv_store(d0, r0); cv_store(d1, r1);
    }
    for (; i < i_hi; ++i) { const int it = gw + i * NGW; if (it < count) { const CvDesc d = conv_desc(a, base + (rev ? count - 1 - it : it), F.lane); f32x4 r[8]; cv_load(d, r); cv_store(d, r); } }
}
__device__ __forceinline__ int conv_nrounds(const Frame& F, int count) { const int NGW = F.G * NWAVES; return (count + NGW - 1) / NGW; }
__device__ __forceinline__ int conv_npre(const Frame& F, int count) { return (int)(((long)blockIdx.x * conv_nrounds(F, count)) / F.G); }
__device__ __forceinline__ void p0_prologue(const Args& a, Frame& F) {
    const int gw = F.vcu * NWAVES + F.wave, NGW = F.G * NWAVES, lane = F.lane;
#if !STAGGER && !SPREAD
    conv_rounds(a, F, CSET_A, CNT_A + CNT_B + CNT_C, 0, conv_nrounds(F, CNT_A + CNT_B + CNT_C), true);
#else
    conv_rounds(a, F, CSET_A, CNT_A, 0, conv_nrounds(F, CNT_A), true);
#endif
    for (int m = gw; m < MTOK; m += NGW) rms_row_to_bf16(a.in[IN_X] + (size_t)m * DM, a.in[IN_PRE], (bf16*)(a.ws + WS_H) + (size_t)m * DM, lane);
}

__device__ __forceinline__ void sgu_phase(const Args& a, Frame& F) {
    constexpr int WP_PITCH = 272, WP_BYTES = 128 * WP_PITCH;
    constexpr int OFF_CV = 2 * WP_BYTES, OFF_MU = OFF_CV + 2 * 3 * 128 * 4, OFF_RS = OFF_MU + 512, OFF_PART = OFF_RS + 512, OFF_GB = OFF_PART + 4096;
    static_assert(OFF_GB + 2 * 2 * HDIM * 4 <= RING_BYTES, "sgu LDS");
    LAS unsigned char* L = F.lds + RING_OFF;
    LAS float* MU = (LAS float*)(L + OFF_MU); LAS float* RS = (LAS float*)(L + OFF_RS); LAS float* PART = (LAS float*)(L + OFF_PART);
    const float* ST = (const float*)(a.ws + WS_ST); const bf16* GVT = (const bf16*)(a.ws + WS_B1); const bf16* UZ = (const bf16*)(a.ws + WS_B0); bf16* Y = (bf16*)(a.ws + WS_B2);
    const float* lng = a.in[IN_ALNG]; const float* lnb = a.in[IN_ALNB]; const float* wsp = a.in[IN_AWS]; const float* bsv = a.in[IN_ABS];
    const int tid = F.tid, lane = F.lane, wave = F.wave, fr = lane & 15, fq = lane >> 4;
    for (int unit = blockIdx.x; unit < (MTOK / CHUNK) * 4; unit += F.G) {
        const int ck = unit >> 2, hg = unit & 3, R0 = ck * CHUNK;
        { const int r = tid & 127, q = tid >> 7; float s = 0.f, ss = 0.f;
#pragma unroll
            for (int j = 0; j < NST / 4; ++j) { const f32x2 p = *(const GAS f32x2*)(ST + ((size_t)(q * (NST / 4) + j) * MTOK + R0 + r) * 2); s += p.x; ss += p.y; }
            PART[(q * 128 + r) * 2] = s; PART[(q * 128 + r) * 2 + 1] = ss; }
        __syncthreads();
        if (tid < 128) { float s = 0.f, ss = 0.f;
#pragma unroll
            for (int q = 0; q < 4; ++q) { s += PART[(q * 128 + tid) * 2]; ss += PART[(q * 128 + tid) * 2 + 1]; }
            const float mean = s * (1.f / EI); float var = ss * (1.f / EI) - mean * mean; var = var > 0.f ? var : 0.f;
            MU[tid] = mean; RS[tid] = 1.f / sqrtf(var + EPS); }
        __syncthreads();
        for (int hh = 0; hh < 4; ++hh) {
            const int h = hg * 4 + hh, buf = hh & 1;
            LAS unsigned char* WP = L + buf * WP_BYTES; LAS float* CV = (LAS float*)(L + OFF_CV) + buf * 384;
            { const int t = tid >> 2, part = tid & 3, s0 = 32 * part;
                const GAS f32x4* wrow = (const GAS f32x4*)(wsp + ((size_t)h * CHUNK + t) * CHUNK + s0);
                float c1 = 0.f, c2 = 0.f;
#pragma unroll
                for (int i = 0; i < 4; ++i) {
                    const f32x4 wa = wrow[2 * i], wb = wrow[2 * i + 1];
                    const f32x4 ra = *(const LAS f32x4*)(RS + s0 + 8 * i), rb = *(const LAS f32x4*)(RS + s0 + 8 * i + 4);
                    const f32x4 ma = *(const LAS f32x4*)(MU + s0 + 8 * i), mb = *(const LAS f32x4*)(MU + s0 + 8 * i + 4);
                    f32x4 ca, cb;
#pragma unroll
                    for (int e = 0; e < 4; ++e) { ca[e] = (s0 + 8 * i + e <= t) ? wa[e] : 0.f; cb[e] = (s0 + 8 * i + 4 + e <= t) ? wb[e] : 0.f; }
                    c2 += (ca.x + ca.y) + (ca.z + ca.w) + (cb.x + cb.y) + (cb.z + cb.w);
                    const u32x4 pk = pack8(ca * ra, cb * rb);
                    c1 += dot4(unpk_lo(pk), ma) + dot4(unpk_hi(pk), mb);
                    *(LAS u32x4*)(WP + t * WP_PITCH + (s0 + 8 * i) * 2) = pk; }
                c1 += __shfl_xor(c1, 1); c1 += __shfl_xor(c1, 2); c2 += __shfl_xor(c2, 1); c2 += __shfl_xor(c2, 2);
                if (part == 0) { CV[t] = c1; CV[128 + t] = c2; CV[256 + t] = bsv[h * CHUNK + t]; }
                LAS float* GB = (LAS float*)(L + OFF_GB) + buf * 2 * HDIM; GB[tid] = lng[h * HDIM + tid]; GB[HDIM + tid] = lnb[h * HDIM + tid]; }
            __syncthreads();
            const int chb = h * HDIM + wave * 64;
            bf16x8 Gf[4][4];
#pragma unroll
            for (int nd = 0; nd < 4; ++nd) { const int ch = chb + 32 * (nd >> 1) + 8 * (fr >> 2) + 4 * (nd & 1) + (fr & 3);
#pragma unroll
                for (int ks = 0; ks < 4; ++ks) Gf[nd][ks] = *(const GAS bf16x8*)(GVT + (size_t)ch * MTOK + R0 + 32 * ks + 8 * fq); }
            const LAS float* GBw = (const LAS float*)(L + OFF_GB) + buf * 2 * HDIM + wave * 64 + 8 * fq;
#pragma unroll 1
            for (int th = 0; th < 2; ++th) {
                u32x4 uzv[4][2];
#pragma unroll
                for (int mq = 0; mq < 4; ++mq)
#pragma unroll
                    for (int p = 0; p < 2; ++p) uzv[mq][p] = *(const GAS u32x4*)(UZ + (size_t)(R0 + 16 * (4 * th + mq) + fr) * EI + chb + 32 * p + 8 * fq);
                f32x4 acc[4][4];
#pragma unroll
                for (int nd = 0; nd < 4; ++nd)
#pragma unroll
                    for (int mq = 0; mq < 4; ++mq) acc[nd][mq] = (f32x4){0.f, 0.f, 0.f, 0.f};
#pragma unroll
                for (int mq = 0; mq < 4; ++mq) { const int mt = 4 * th + mq;
#pragma unroll
                    for (int ks = 0; ks < 4; ++ks) if (ks <= mt / 2) {
                        const bf16x8 wf = *(const LAS bf16x8*)(WP + (16 * mt + fr) * WP_PITCH + (32 * ks + 8 * fq) * 2);
#pragma unroll
                        for (int nd = 0; nd < 4; ++nd) acc[nd][mq] = __builtin_amdgcn_mfma_f32_16x16x32_bf16(Gf[nd][ks], wf, acc[nd][mq], 0, 0, 0); } }
#pragma unroll
                for (int mq = 0; mq < 4; ++mq) { const int t = 16 * (4 * th + mq) + fr; const float c1 = CV[t], c2 = CV[128 + t], bs = CV[256 + t];
#pragma unroll
                    for (int p = 0; p < 2; ++p) { const size_t off = (size_t)(R0 + t) * EI + chb + 32 * p + 8 * fq;
                        const u32x4 uz = uzv[mq][p];
                        const f32x4 lg0 = *(const LAS f32x4*)(GBw + 32 * p), lg1 = *(const LAS f32x4*)(GBw + 32 * p + 4), lb0 = *(const LAS f32x4*)(GBw + HDIM + 32 * p), lb1 = *(const LAS f32x4*)(GBw + HDIM + 32 * p + 4);
                        const f32x4 sv0 = lg0 * (acc[2 * p][mq] - c1) + (lb0 * c2 + bs), sv1 = lg1 * (acc[2 * p + 1][mq] - c1) + (lb1 * c2 + bs);
                        *(GAS u32x4*)(Y + off) = pack8(unpk_lo(uz) * sv0, unpk_hi(uz) * sv1); } }
            }
        }
        __syncthreads();
    }
}

template <bool FINAL>
__device__ __forceinline__ void norm_phase(const bf16* M, const float* xin, float* xout, const float* gpost, const float* gpre, bf16* H, bf16* x1b, Frame& F) {
    const int gw = F.vcu * NWAVES + F.wave, NGW = F.G * NWAVES, lane = F.lane;
    for (int m = gw; m < MTOK; m += NGW) {
        const GAS u32x4* mr = (const GAS u32x4*)(M + (size_t)m * DM) + lane;
        u32x4 mv[8]; float ss = 0.f;
#pragma unroll
        for (int j = 0; j < 8; ++j) { mv[j] = mr[64 * j]; const f32x4 lo = unpk_lo(mv[j]), hi = unpk_hi(mv[j]); ss += dot4(lo, lo) + dot4(hi, hi); }
        const float rm = 1.f / sqrtf(wave_sum(ss) * (1.f / DM) + EPS);
        f32x4 x1[16]; float s2 = 0.f;
#pragma unroll
        for (int j = 0; j < 8; ++j) { const size_t e0 = (size_t)8 * (lane + 64 * j);
            f32x4 xa, xb;
            if (FINAL && x1b) { const u32x4 xp = *(const GAS u32x4*)(x1b + (size_t)m * DM + e0); xa = unpk_lo(xp); xb = unpk_hi(xp); }
            else { xa = *(const GAS f32x4*)(xin + (size_t)m * DM + e0); xb = *(const GAS f32x4*)(xin + (size_t)m * DM + e0 + 4); }
            const f32x4 ga = *(const GAS f32x4*)(gpost + e0), gb = *(const GAS f32x4*)(gpost + e0 + 4);
            x1[2 * j] = xa + unpk_lo(mv[j]) * rm * ga; x1[2 * j + 1] = xb + unpk_hi(mv[j]) * rm * gb;
            if (!FINAL && x1b) { const u32x4 xp = pack8(x1[2 * j], x1[2 * j + 1]); *(GAS u32x4*)(x1b + (size_t)m * DM + e0) = xp; x1[2 * j] = unpk_lo(xp); x1[2 * j + 1] = unpk_hi(xp); }
            else { *(GAS f32x4*)(xout + (size_t)m * DM + e0) = x1[2 * j]; *(GAS f32x4*)(xout + (size_t)m * DM + e0 + 4) = x1[2 * j + 1]; }
            s2 += dot4(x1[2 * j], x1[2 * j]) + dot4(x1[2 * j + 1], x1[2 * j + 1]); }
        if constexpr (!FINAL) {
            const float rx = 1.f / sqrtf(wave_sum(s2) * (1.f / DM) + EPS);
#pragma unroll
            for (int j = 0; j < 8; ++j) { const size_t e0 = (size_t)8 * (lane + 64 * j);
                const f32x4 ga = *(const GAS f32x4*)(gpre + e0), gb = *(const GAS f32x4*)(gpre + e0 + 4);
                *(GAS u32x4*)(H + (size_t)m * DM + e0) = pack8(x1[2 * j] * rx * ga, x1[2 * j + 1] * rx * gb); }
        }
    }
}

template <int W>
__device__ __forceinline__ void pool_unit(const bf16* P, bf16* O, int R0, int c0) {
    const int tseq0 = R0 & (SEQ - 1);
    f32x4 Sa = (f32x4){0.f, 0.f, 0.f, 0.f}, Sb = Sa; u32x4 ring[W];
#pragma unroll
    for (int j = 0; j < W; ++j) {
        u32x4 v = (u32x4){0u, 0u, 0u, 0u};
        if (tseq0 - W + j >= 0) v = *(const GAS u32x4*)(P + (size_t)(R0 - W + j) * EI + c0);
        ring[j] = v; if (j >= 1) { Sa += unpk_lo(v); Sb += unpk_hi(v); } }
    for (int t = 0; t < 64; t += W) {
#pragma unroll
        for (int j = 0; j < W; ++j) {
            const size_t off = (size_t)(R0 + t + j) * EI + c0;
            const u32x4 cur = *(const GAS u32x4*)(P + off);
            const f32x4 ca = unpk_lo(cur), cb = unpk_hi(cur);
            Sa += ca; Sb += cb;
            const int pos = tseq0 + t + j + 1; const float inv = 1.f / (float)(pos < W ? pos : W);
            *(GAS u32x4*)(O + off) = pack8(Sa * inv - ca, Sb * inv - cb);
            ring[j] = cur;
            const u32x4 old = ring[(j + 1) % W]; Sa -= unpk_lo(old); Sb -= unpk_hi(old);
        }
    }
}
__device__ __forceinline__ void pool_phase(const Args& a, Frame& F) {
    const bf16* P = (const bf16*)(a.ws + WS_B1); bf16* O = (bf16*)(a.ws + WS_B2);
    const int gw = F.vcu * NWAVES + F.wave, NGW = F.G * NWAVES;
    for (int wu = gw; wu < (MTOK / 64) * (EI / 512); wu += NGW) {
        const int rb = wu >> 4, cb = wu & 15, R0 = 64 * rb, c0 = 512 * cb + 8 * F.lane, g = cb >> 2;
        if (g == 0) pool_unit<2>(P, O, R0, c0); else if (g == 1) pool_unit<4>(P, O, R0, c0); else if (g == 2) pool_unit<8>(P, O, R0, c0); else pool_unit<16>(P, O, R0, c0);
    }
}

__device__ __forceinline__ void poolh_phase(const Args& a, Frame& F) {
    const bf16* H = (const bf16*)(a.ws + WS_H); bf16* PH = (bf16*)(a.ws + WS_PH);
    const int gw = F.vcu * NWAVES + F.wave, NGW = F.G * NWAVES;
    for (int wu = gw; wu < (MTOK / 32) * (DM / 512); wu += NGW) {
        const int rb = wu >> 3, cb = wu & 7, R0 = 32 * rb, c0 = 512 * cb + 8 * F.lane, tseq0 = R0 & (SEQ - 1);
        u32x4 ring[16];
#pragma unroll
        for (int j = 0; j < 16; ++j) { u32x4 v = (u32x4){0u, 0u, 0u, 0u}; if (tseq0 - 16 + j >= 0) v = *(const GAS u32x4*)(H + (size_t)(R0 - 16 + j) * DM + c0); ring[j] = v; }
        f32x4 Sa[4], Sb[4];
#pragma unroll
        for (int g = 0; g < 4; ++g) { Sa[g] = (f32x4){0.f, 0.f, 0.f, 0.f}; Sb[g] = (f32x4){0.f, 0.f, 0.f, 0.f};
#pragma unroll
            for (int i = 1; i <= (2 << g); ++i) { Sa[g] += unpk_lo(ring[16 - i]); Sb[g] += unpk_hi(ring[16 - i]); } }
        const GAS u32x4* hp = (const GAS u32x4*)(H + (size_t)R0 * DM + c0);
        GAS u32x4* pp = (GAS u32x4*)(PH + (size_t)R0 * DM + c0);
        constexpr size_t ROWV = DM / 8, GRPV = (size_t)MTOK * DM / 8;
#pragma unroll 1
        for (int t = 0; t < 32; t += 16) {
#pragma unroll
            for (int jb = 0; jb < 16; jb += 8) {
                u32x4 nx[8];
#pragma unroll
                for (int q = 0; q < 8; ++q) nx[q] = hp[(size_t)q * ROWV];
                hp += 8 * ROWV;
#pragma unroll
                for (int q = 0; q < 8; ++q) { const int j = jb + q;
                    const u32x4 cur = nx[q];
                    const f32x4 ca = unpk_lo(cur), cb4 = unpk_hi(cur);
                    int pos = tseq0 + t + j + 1; asm volatile("" : "+s"(pos));
#pragma unroll
                    for (int g = 0; g < 4; ++g) { const int W = 2 << g; u32x4 old = ring[(j - W) & 15]; asm volatile("" : "+v"(old));
                        Sa[g] += ca - unpk_lo(old); Sb[g] += cb4 - unpk_hi(old);
                        const float inv = 1.f / (float)(pos < W ? pos : W);
                        pp[(size_t)g * GRPV] = pack8(Sa[g] * inv - ca, Sb[g] * inv - cb4); }
                    ring[j] = cur; pp += ROWV; }
                asm volatile("" ::: "memory");
            }
        }
    }
}

__global__ void __launch_bounds__(NWAVES * 64, 2) skel_fwd(Args args) {
    extern __shared__ __attribute__((aligned(16))) unsigned char lds[];
    Frame F;
    F.lds = (LAS unsigned char*)lds;
    F.MISC = (volatile LAS unsigned*)(F.lds + MISC_OFF);
    F.tid = threadIdx.x; F.lane = F.tid & 63; F.wave = __builtin_amdgcn_readfirstlane(F.tid >> 6);
    F.G = gridDim.x; { const int bx = blockIdx.x; F.vcu = (F.G % 8 == 0) ? (bx % 8) * (F.G / 8) + bx / 8 : bx; }
    unsigned char* ws = args.ws;
    F.ctl = (gu32*)(ws + WS_CTL);
    for (int u = F.tid; u < (LDS_BYTES - LDSCTL_OFF) / 4; u += NWAVES * 64) ((LAS unsigned*)(F.lds + LDSCTL_OFF))[u] = 0u;
    __syncthreads();
    XcdBarrier bar = xcd_barrier_post((unsigned*)(F.ctl + CW_BAR), F.MISC + 8);
    const int lo = args.ph_lo, hi = args.ph_hi;
#ifndef PH_MASK
#define PH_MASK 0x3ff
#endif
#define IN(k) ((((PH_MASK) >> (k)) & 1) && lo <= (k) && (k) < hi)
#define BOTH(k) (IN(k) && IN((k) + 1))
    bf16* const W1UZ = (bf16*)(ws + WS_W1UZ); bf16* const W1V = (bf16*)(ws + WS_W1V); bf16* const W2 = (bf16*)(ws + WS_W2); bf16* const W3 = (bf16*)(ws + WS_W3);
    bf16* const W4 = (bf16*)(ws + WS_W4); bf16* const W5 = (bf16*)(ws + WS_W5); bf16* const Hb = (bf16*)(ws + WS_H); bf16* const B0 = (bf16*)(ws + WS_B0);
    bf16* const B1 = (bf16*)(ws + WS_B1); bf16* const B2 = (bf16*)(ws + WS_B2); bf16* const Mb = (bf16*)(ws + WS_M); float* const ST = (float*)(ws + WS_ST);

    unsigned long long pc_t0 = 0, pc_r0 = 0, pc_mhz = 0;
#define PCLK_BEGIN(k) do { if (PROBE_CLK == (k) + 1 || PROBE_DUR == (k) + 1) { pc_t0 = __builtin_amdgcn_s_memtime(); pc_r0 = __builtin_amdgcn_s_memrealtime(); } } while (0)
#define PCLK_END(k) do { if (PROBE_CLK == (k) + 1) { const unsigned long long t1 = __builtin_amdgcn_s_memtime(), r1 = __builtin_amdgcn_s_memrealtime(); pc_mhz = (t1 - pc_t0) * 100ull / (r1 - pc_r0 + 1ull); } \
        if (PROBE_DUR == (k) + 1) { pc_mhz = (__builtin_amdgcn_s_memrealtime() - pc_r0) / 100ull; } } while (0)
    PCLK_BEGIN(0);
    if (IN(0)) { p0_prologue(args, F); if ((REPEAT_MASK >> 0) & 1) { __syncthreads(); p0_prologue(args, F); } if (BOTH(0)) xcd_barrier(bar); }

    PCLK_END(0);
    PCLK_BEGIN(1);
    if (IN(1)) {
#pragma unroll
        for (int rep = 0; rep < 1 + ((REPEAT_MASK >> 1) & 1); ++rep) { if (rep) __syncthreads();
        if (DELAY_P1_US > 0 && rep == 0) { const unsigned long long r0 = __builtin_amdgcn_s_memrealtime(), ticks = (unsigned long long)(blockIdx.x >> 3) * (DELAY_P1_US * 100ull) / 32ull; while (__builtin_amdgcn_s_memrealtime() - r0 < ticks) __builtin_amdgcn_s_sleep(8); __syncthreads(); }
        if (STAGGER) { conv_rounds(args, F, CSET_B, CNT_B, 0, conv_npre(F, CNT_B)); asm volatile("s_waitcnt vmcnt(0)" ::: "memory"); __syncthreads(); }
        { pg8::Gemm g{Hb, W1UZ, DM, DM, DM, 0, 0, 0, 0}; pg8::StaticOrder S; S.init(MTOK, 2 * EI, F.G, (int)blockIdx.x);
          pg8::EpiUZ E{B0, EI};
          pg8::gemm_phase<pg8::EpiUZ, pg8::StaticOrder, GALIGN, GSP2, (PROBE_EPI != 0)>(F.lds + RING_OFF, g, S, E); }
        __syncthreads();
        { pg8::Gemm g{W1V, Hb, DM, DM, DM, 0, 0, 0, 0}; pg8::StaticOrder S; S.init(EI, MTOK, F.G, (int)blockIdx.x);
          pg8::EpiGvT E{B1, MTOK, ST, MTOK};
          pg8::gemm_phase<pg8::EpiGvT, pg8::StaticOrder, GALIGN, GSP2>(F.lds + RING_OFF, g, S, E); }
        if (STAGGER) conv_rounds(args, F, CSET_B, CNT_B, conv_npre(F, CNT_B), conv_nrounds(F, CNT_B));
        }
        if (BOTH(1)) xcd_barrier(bar);
    }

    PCLK_END(1);
    PCLK_BEGIN(2);
    if (IN(2)) { if (SPREAD) conv_rounds(args, F, CSET_B, CNT_B, 0, conv_nrounds(F, CNT_B), true); sgu_phase(args, F); if ((REPEAT_MASK >> 2) & 1) { __syncthreads(); sgu_phase(args, F); } if (BOTH(2)) xcd_barrier(bar); }

    PCLK_END(2);
    PCLK_BEGIN(3);
    if (IN(3)) {
#pragma unroll
        for (int rep = 0; rep < 1 + ((REPEAT_MASK >> 3) & 1); ++rep) { if (rep) __syncthreads();
        pg8::Gemm g{B2, W2, EI, EI, EI, 0, 0, 0, 0}; pg8::StaticOrder S; S.init(MTOK, DM, F.G, (int)blockIdx.x);
        pg8::EpiPlain E{Mb, DM};
        pg8::gemm_phase<pg8::EpiPlain, pg8::StaticOrder, GALIGN, GSP2>(F.lds + RING_OFF, g, S, E);
        }
        if (BOTH(3)) xcd_barrier(bar);
    }

    PCLK_END(3);
    PCLK_BEGIN(4);
    if (IN(4)) { if (SPREAD) conv_rounds(args, F, CSET_C, CNT_C, 0, conv_nrounds(F, CNT_C), true); norm_phase<false>(Mb, args.in[IN_X], args.out, args.in[IN_POST], args.in[IN_PRE] + DM, Hb, X1BF16 ? (bf16*)(ws + WS_X1B) : nullptr, F); if ((REPEAT_MASK >> 4) & 1) norm_phase<false>(Mb, args.in[IN_X], args.out, args.in[IN_POST], args.in[IN_PRE] + DM, Hb, X1BF16 ? (bf16*)(ws + WS_X1B) : nullptr, F); if (BOTH(4)) xcd_barrier(bar); }

#if WCOMB
    PCLK_END(4);
    PCLK_BEGIN(5);
    if (IN(5)) {
#pragma unroll
        for (int rep = 0; rep < 1 + ((REPEAT_MASK >> 5) & 1); ++rep) { if (rep) __syncthreads();
#ifndef NO_POOLH
        poolh_phase(args, F);
#endif
        __syncthreads();
        { pg8::Gemm g{Hb, W3, DM, DM, DM, 0, 0, 0, 0}; pg8::StaticOrder S; S.init(MTOK, EI, F.G, (int)blockIdx.x);
          pg8::EpiPZ E{nullptr, B0, EI, 0};
          pg8::gemm_phase<pg8::EpiPZ, pg8::StaticOrder, GALIGN, GSP2>(F.lds + RING_OFF, g, S, E); }
        __syncthreads();
        { pg8::Gemm g{W4, (const bf16*)(ws + WS_W3P), GWID, EI, GWID, 0, 0, GWID / 256, (size_t)GWID * 2}; pg8::StaticOrder S; S.init(EI, DM, F.G, (int)blockIdx.x);
          pg8::EpiPlain E{(bf16*)(ws + WS_WC), DM};
          pg8::gemm_phase<pg8::EpiPlain, pg8::StaticOrder, GALIGN, GSP2>(F.lds + RING_OFF, g, S, E); }
        }
        if (BOTH(5)) xcd_barrier(bar);
    }
    PCLK_END(5);
    PCLK_BEGIN(6);
    PCLK_END(6);
    PCLK_BEGIN(7);
    if (IN(7)) {
#pragma unroll
        for (int rep = 0; rep < 1 + ((REPEAT_MASK >> 7) & 1); ++rep) { if (rep) __syncthreads();
        pg8::Gemm g{(const bf16*)(ws + WS_PH), (const bf16*)(ws + WS_WC), DM, DM, DM, GWID / 256, (size_t)MTOK * DM * 2, 0, 0}; pg8::StaticOrder S; S.init(MTOK, EI, F.G, (int)blockIdx.x);
        pg8::EpiMix E{B0, (bf16*)(ws + WS_Y1), EI, args.in[IN_BBGRP], args.in[IN_BSCALE]};
        pg8::gemm_phase<pg8::EpiMix, pg8::StaticOrder, GALIGN, GSP2>(F.lds + RING_OFF, g, S, E);
        }
        if (BOTH(7)) xcd_barrier(bar);
    }
#else
    PCLK_END(4);
    PCLK_BEGIN(5);
    if (IN(5)) {
#pragma unroll
        for (int rep = 0; rep < 1 + ((REPEAT_MASK >> 5) & 1); ++rep) { if (rep) __syncthreads();
        if (STAGGER) { conv_rounds(args, F, CSET_C, CNT_C, 0, conv_npre(F, CNT_C)); asm volatile("s_waitcnt vmcnt(0)" ::: "memory"); __syncthreads(); }
        pg8::Gemm g{Hb, W3, DM, DM, DM, 0, 0, 0, 0}; pg8::StaticOrder S; S.init(MTOK, 2 * EI, F.G, (int)blockIdx.x);
        pg8::EpiPZ E{B1, B0, EI, EI / 256};
        pg8::gemm_phase<pg8::EpiPZ, pg8::StaticOrder, GALIGN, GSP2>(F.lds + RING_OFF, g, S, E);
        if (STAGGER) conv_rounds(args, F, CSET_C, CNT_C, conv_npre(F, CNT_C), conv_nrounds(F, CNT_C));
        }
        if (BOTH(5)) xcd_barrier(bar);
    }

    PCLK_END(5);
    PCLK_BEGIN(6);
    if (IN(6)) { pool_phase(args, F); if ((REPEAT_MASK >> 6) & 1) pool_phase(args, F); if (BOTH(6)) xcd_barrier(bar); }

    PCLK_END(6);
    PCLK_BEGIN(7);
    if (IN(7)) {
#pragma unroll
        for (int rep = 0; rep < 1 + ((REPEAT_MASK >> 7) & 1); ++rep) { if (rep) __syncthreads();
        pg8::Gemm g{B2, W4, EI, GWID, GWID, GWID / 256, (size_t)GWID * 2, 0, 0}; pg8::StaticOrder S; S.init(MTOK, EI, F.G, (int)blockIdx.x);
        pg8::EpiMix E{B0, B1, EI, args.in[IN_BBGRP], args.in[IN_BSCALE]};
        pg8::gemm_phase<pg8::EpiMix, pg8::StaticOrder, GALIGN, GSP2>(F.lds + RING_OFF, g, S, E);
        }
        if (BOTH(7)) xcd_barrier(bar);
    }

#endif

    PCLK_END(7);
    PCLK_BEGIN(8);
    if (IN(8)) {
#pragma unroll
        for (int rep = 0; rep < 1 + ((REPEAT_MASK >> 8) & 1); ++rep) { if (rep) __syncthreads();
        pg8::Gemm g{WCOMB ? (const bf16*)(ws + WS_Y1) : (const bf16*)B1, W5, EI, EI, EI, 0, 0, 0, 0}; pg8::StaticOrder S; S.init(MTOK, DM, F.G, (int)blockIdx.x);
        pg8::EpiPlain E{Mb, DM};
        pg8::gemm_phase<pg8::EpiPlain, pg8::StaticOrder, GALIGN, GSP2>(F.lds + RING_OFF, g, S, E);
        }
        if (BOTH(8)) xcd_barrier(bar);
    }

    PCLK_END(8);
    PCLK_BEGIN(9);
    if (IN(9)) {
        norm_phase<true>(Mb, args.out, args.out, args.in[IN_POST] + DM, nullptr, nullptr, X1BF16 ? (bf16*)(ws + WS_X1B) : nullptr, F);
        if (__hip_atomic_load(F.ctl + CW_BAR + XB_TMO, RLX_AGENT) != 0u) {
            const int gw = F.vcu * NWAVES + F.wave, NGW = F.G * NWAVES; const float q = __builtin_nanf("");
            for (int m = gw; m < MTOK; m += NGW) { GAS f32x4* o = (GAS f32x4*)(args.out + (size_t)m * DM) + F.lane;
#pragma unroll
                for (int j = 0; j < 16; ++j) o[64 * j] = (f32x4){q, q, q, q}; } }
    }
    PCLK_END(9);
    if (PROBE_EPI != 0 && blockIdx.x == 0 && F.tid == 0) { const LAS unsigned long long* st = (const LAS unsigned long long*)(F.lds + RING_OFF + pg8::STAGE_BYTES + 1024);
        const unsigned long long v = PROBE_EPI == 1 ? (st[1] - st[0]) / 10ull : PROBE_EPI == 2 ? (st[2] - st[1]) / 10ull : PROBE_EPI == 3 ? (st[3] - st[2]) / 64ull : (st[4] - st[1]) / 100ull;
        const unsigned long long r0 = __builtin_amdgcn_s_memrealtime(), ticks = (v > 6000ull ? 6000ull : v) * 100ull; while (__builtin_amdgcn_s_memrealtime() - r0 < ticks) __builtin_amdgcn_s_sleep(32); }
    if ((PROBE_CLK != 0 || PROBE_DUR != 0) && blockIdx.x == 0 && F.tid == 0) { const unsigned long long r0 = __builtin_amdgcn_s_memrealtime(); const unsigned long long ticks = (pc_mhz > 5000ull ? 5000ull : pc_mhz) * 100ull;
        while (__builtin_amdgcn_s_memrealtime() - r0 < ticks) __builtin_amdgcn_s_sleep(32); }
#undef IN
#undef BOTH
}

#if NAIVE_MASK != 0
#if WCOMB && (NAIVE_MASK & 0xE0)
#error "the reference implementations of phases 5-7 follow the literal order: build them with WCOMB 0"
#endif
__device__ __forceinline__ bf16 nv_f2bf(float f) { unsigned u = __float_as_uint(f); u += 0x7fffu + ((u >> 16) & 1u); return (bf16)(u >> 16); }
__device__ __forceinline__ float nv_bf2f(bf16 b) { return __uint_as_float(((unsigned)b) << 16); }
__device__ __forceinline__ float nv_gelu(float v) { return 0.5f * v * (1.0f + erff(v * 0.70710678118654752f)); }
__device__ __forceinline__ float nv_silu(float v) { return v / (1.0f + expf(-v)); }
__global__ void nv_transpose(const float* W, int ldw, int K, int Nd, bf16* WT, int mode) {
    const size_t total = (size_t)Nd * K;
    for (size_t i = (size_t)blockIdx.x * blockDim.x + threadIdx.x; i < total; i += (size_t)gridDim.x * blockDim.x) {
        const int r = (int)(i / K), k = (int)(i % K); int c = r;
        if (mode == 1) { const int t = r >> 8, j = r & 255; c = j < 128 ? 128 * t + j : 2 * EI + 128 * t + (j - 128); }
        if (mode == 2) c = EI + r;
        WT[i] = nv_f2bf(W[(size_t)k * ldw + c]); }
}
__global__ void nv_rms_h(const float* x, const float* g, bf16* H) {
    const int m = blockIdx.x, lane = threadIdx.x; float s = 0.f;
    for (int c = lane; c < DM; c += 64) { const float v = x[(size_t)m * DM + c]; s += v * v; }
    for (int o = 1; o < 64; o <<= 1) s += __shfl_xor(s, o);
    const float rstd = 1.f / sqrtf(s / DM + EPS);
    for (int c = lane; c < DM; c += 64) H[(size_t)m * DM + c] = nv_f2bf(x[(size_t)m * DM + c] * rstd * g[c]);
}
struct NvUZ { bf16* U; bf16* Zt; __device__ void operator()(int r, int c, float v) const { const int t = c >> 8, j = c & 255;
    if (j < 128) U[(size_t)r * EI + 128 * t + j] = nv_f2bf(nv_gelu(v)); else Zt[(size_t)r * EI + 128 * t + (j - 128)] = nv_f2bf(nv_silu(v)); } };
struct NvGvT { bf16* O; __device__ void operator()(int r, int c, float v) const { O[(size_t)c * MTOK + r] = nv_f2bf(nv_gelu(v)); } };
struct NvPlain { bf16* O; int ldc; int pad; __device__ void operator()(int r, int c, float v) const { O[(size_t)r * ldc + c] = nv_f2bf(v); } };
struct NvPZ { bf16* P; bf16* SZ; __device__ void operator()(int r, int c, float v) const { if (c < EI) P[(size_t)r * EI + c] = nv_f2bf(v); else SZ[(size_t)r * EI + c - EI] = nv_f2bf(nv_silu(v)); } };
struct NvMix { const bf16* SZ; bf16* Y; const float* bgrp; const float* scale; int g; int pad; __device__ void operator()(int r, int c, float v) const { const int ch = g * GWID + c;
    Y[(size_t)r * EI + ch] = nv_f2bf((v + bgrp[ch]) * scale[ch] * nv_bf2f(SZ[(size_t)r * EI + ch])); } };
template <class Epi> __global__ void __launch_bounds__(256) nv_gemm(const bf16* A, int lda, const bf16* Bt, int ldb, int K, Epi epi) {
    __shared__ float As[16][65], Bs[16][65];
    const int tid = threadIdx.x, tx = tid & 15, ty = tid >> 4, row0 = blockIdx.y * 64, col0 = blockIdx.x * 64;
    float acc[4][4];
#pragma unroll
    for (int i = 0; i < 4; ++i)
#pragma unroll
        for (int j = 0; j < 4; ++j) acc[i][j] = 0.f;
    const int lr = tid >> 2, lk = (tid & 3) * 4;
    for (int k0 = 0; k0 < K; k0 += 16) {
#pragma unroll
        for (int i = 0; i < 4; ++i) { As[lk + i][lr] = nv_bf2f(A[(size_t)(row0 + lr) * lda + k0 + lk + i]); Bs[lk + i][lr] = nv_bf2f(Bt[(size_t)(col0 + lr) * ldb + k0 + lk + i]); }
        __syncthreads();
#pragma unroll
        for (int k = 0; k < 16; ++k) { float av[4], bv[4];
#pragma unroll
            for (int i = 0; i < 4; ++i) { av[i] = As[k][ty * 4 + i]; bv[i] = Bs[k][tx * 4 + i]; }
#pragma unroll
            for (int i = 0; i < 4; ++i)
#pragma unroll
                for (int j = 0; j < 4; ++j) acc[i][j] += av[i] * bv[j]; }
        __syncthreads();
    }
#pragma unroll
    for (int i = 0; i < 4; ++i)
#pragma unroll
        for (int j = 0; j < 4; ++j) epi(row0 + ty * 4 + i, col0 + tx * 4 + j, acc[i][j]);
}
__global__ void nv_mul(bf16* U, const bf16* Zt, size_t n) { for (size_t i = (size_t)blockIdx.x * blockDim.x + threadIdx.x; i < n; i += (size_t)gridDim.x * blockDim.x) U[i] = nv_f2bf(nv_bf2f(U[i]) * nv_bf2f(Zt[i])); }
__global__ void nv_stats(const bf16* GVT, float* ST) {
    const int tok = blockIdx.x * blockDim.x + threadIdx.x; if (tok >= MTOK) return; float s = 0.f, ss = 0.f;
    for (int ch = 0; ch < EI; ++ch) { const float v = nv_bf2f(GVT[(size_t)ch * MTOK + tok]); s += v; ss += v * v; }
    ST[(size_t)tok * 2] = s; ST[(size_t)tok * 2 + 1] = ss;
    for (int p = 1; p < NST; ++p) { ST[((size_t)p * MTOK + tok) * 2] = 0.f; ST[((size_t)p * MTOK + tok) * 2 + 1] = 0.f; }
}
__global__ void nv_murs(const float* ST, float* MR) {
    const int tok = blockIdx.x * blockDim.x + threadIdx.x; if (tok >= MTOK) return; float s = 0.f, ss = 0.f;
    for (int p = 0; p < NST; ++p) { s += ST[((size_t)p * MTOK + tok) * 2]; ss += ST[((size_t)p * MTOK + tok) * 2 + 1]; }
    const float mean = s / EI; float var = ss / EI - mean * mean; var = var > 0.f ? var : 0.f; MR[tok * 2] = mean; MR[tok * 2 + 1] = 1.f / sqrtf(var + EPS);
}
__global__ void nv_sgu(const bf16* GVT, const float* MR, const bf16* UZ, const float* lng, const float* lnb, const float* wsp, const float* bsv, bf16* Y) {
    const size_t total = (size_t)MTOK * EI;
    for (size_t i = (size_t)blockIdx.x * blockDim.x + threadIdx.x; i < total; i += (size_t)gridDim.x * blockDim.x) {
        const int ch = (int)(i / MTOK), tok = (int)(i % MTOK), h = ch / HDIM, t = tok & (CHUNK - 1), R0 = tok - t;
        float sv = 0.f;
        for (int s = 0; s <= t; ++s) { const float vn = (nv_bf2f(GVT[(size_t)ch * MTOK + R0 + s]) - MR[(R0 + s) * 2]) * MR[(R0 + s) * 2 + 1] * lng[ch] + lnb[ch];
            sv += wsp[((size_t)h * CHUNK + t) * CHUNK + s] * vn; }
        sv += bsv[h * CHUNK + t];
        Y[(size_t)tok * EI + ch] = nv_f2bf(nv_bf2f(UZ[(size_t)tok * EI + ch]) * sv); }
}
__global__ void nv_pool(const bf16* P, bf16* O) {
    const size_t total = (size_t)MTOK * EI;
    for (size_t i = (size_t)blockIdx.x * blockDim.x + threadIdx.x; i < total; i += (size_t)gridDim.x * blockDim.x) {
        const int tok = (int)(i / EI), ch = (int)(i % EI), g = ch / GWID, W = 2 << g, tseq = tok & (SEQ - 1), cnt = (tseq + 1 < W) ? tseq + 1 : W;
        float s = 0.f; for (int j = 0; j < cnt; ++j) s += nv_bf2f(P[(size_t)(tok - j) * EI + ch]);
        O[i] = nv_f2bf(s / (float)cnt - nv_bf2f(P[i])); }
}
static void launch_naive_phase(int k, const Args& a, hipStream_t stream) {
    unsigned char* ws = a.ws;
    bf16* W1UZ = (bf16*)(ws + WS_W1UZ); bf16* W1V = (bf16*)(ws + WS_W1V); bf16* W2 = (bf16*)(ws + WS_W2); bf16* W3 = (bf16*)(ws + WS_W3); bf16* W4 = (bf16*)(ws + WS_W4); bf16* W5 = (bf16*)(ws + WS_W5);
    bf16* Hb = (bf16*)(ws + WS_H); bf16* B0 = (bf16*)(ws + WS_B0); bf16* B1 = (bf16*)(ws + WS_B1); bf16* B2 = (bf16*)(ws + WS_B2); bf16* Mb = (bf16*)(ws + WS_M); float* ST = (float*)(ws + WS_ST); float* MR = (float*)(ws + WS_DBG);
    const dim3 blk(256);
    switch (k) {
    case 0:
        hipLaunchKernelGGL(nv_transpose, dim3(8192), blk, 0, stream, a.in[IN_AWIN], 3 * EI, DM, 2 * EI, W1UZ, 1);
        hipLaunchKernelGGL(nv_transpose, dim3(8192), blk, 0, stream, a.in[IN_AWIN], 3 * EI, DM, EI, W1V, 2);
        hipLaunchKernelGGL(nv_transpose, dim3(8192), blk, 0, stream, a.in[IN_AWOUT], DM, EI, DM, W2, 0);
        hipLaunchKernelGGL(nv_transpose, dim3(8192), blk, 0, stream, a.in[IN_BWIN], 2 * EI, DM, 2 * EI, W3, 0);
        for (int g = 0; g < NGRP; ++g) hipLaunchKernelGGL(nv_transpose, dim3(4096), blk, 0, stream, a.in[IN_BWGRP] + (size_t)g * GWID * GWID, GWID, GWID, GWID, W4 + (size_t)g * GWID * GWID, 0);
        hipLaunchKernelGGL(nv_transpose, dim3(8192), blk, 0, stream, a.in[IN_BWOUT], DM, EI, DM, W5, 0);
        hipLaunchKernelGGL(nv_rms_h, dim3(MTOK), dim3(64), 0, stream, a.in[IN_X], a.in[IN_PRE], Hb);
        break;
    case 1:
        hipLaunchKernelGGL(nv_gemm<NvUZ>, dim3(2 * EI / 64, MTOK / 64), blk, 0, stream, (const bf16*)Hb, DM, (const bf16*)W1UZ, DM, DM, NvUZ{B0, B2});
        hipLaunchKernelGGL(nv_mul, dim3(8192), blk, 0, stream, B0, (const bf16*)B2, (size_t)MTOK * EI);
        hipLaunchKernelGGL(nv_gemm<NvGvT>, dim3(EI / 64, MTOK / 64), blk, 0, stream, (const bf16*)Hb, DM, (const bf16*)W1V, DM, DM, NvGvT{B1});
        hipLaunchKernelGGL(nv_stats, dim3(MTOK / 256), blk, 0, stream, (const bf16*)B1, ST);
        break;
    case 2:
        hipLaunchKernelGGL(nv_murs, dim3(MTOK / 256), blk, 0, stream, (const float*)ST, MR);
        hipLaunchKernelGGL(nv_sgu, dim3(16384), blk, 0, stream, (const bf16*)B1, (const float*)MR, (const bf16*)B0, a.in[IN_ALNG], a.in[IN_ALNB], a.in[IN_AWS], a.in[IN_ABS], B2);
        break;
    case 3: hipLaunchKernelGGL(nv_gemm<NvPlain>, dim3(DM / 64, MTOK / 64), blk, 0, stream, (const bf16*)B2, EI, (const bf16*)W2, EI, EI, NvPlain{Mb, DM, 0}); break;
    case 5: hipLaunchKernelGGL(nv_gemm<NvPZ>, dim3(2 * EI / 64, MTOK / 64), blk, 0, stream, (const bf16*)Hb, DM, (const bf16*)W3, DM, DM, NvPZ{B1, B0}); break;
    case 6: hipLaunchKernelGGL(nv_pool, dim3(16384), blk, 0, stream, (const bf16*)B1, B2); break;
    case 7:
        for (int g = 0; g < NGRP; ++g) hipLaunchKernelGGL(nv_gemm<NvMix>, dim3(GWID / 64, MTOK / 64), blk, 0, stream, (const bf16*)B2 + (size_t)g * GWID, EI, (const bf16*)W4 + (size_t)g * GWID * GWID, GWID, GWID,
                                                          NvMix{(const bf16*)B0, B1, a.in[IN_BBGRP], a.in[IN_BSCALE], g, 0});
        break;
    case 8: hipLaunchKernelGGL(nv_gemm<NvPlain>, dim3(DM / 64, MTOK / 64), blk, 0, stream, (const bf16*)B1, EI, (const bf16*)W5, EI, EI, NvPlain{Mb, DM, 0}); break;
    default: break;
    }
}
#endif

extern "C" void kernel_launch(void* const* d_in, const int* in_sizes, int n_in, void* d_out, int out_size, void* d_ws, size_t ws_size, hipStream_t stream) {
    static int grid = 0;
    if (grid == 0) {
        if (n_in != N_IN || in_sizes[0] != MTOK * DM || out_size != MTOK * DM || ws_size < WS_END) {
            fprintf(stderr, "kernel_launch: built for %d inputs, x and out of %d floats, >= %zu bytes of workspace; got n_in %d, in0 %d, out %d, ws %zu; nothing launched\n", (int)N_IN, MTOK * DM, (size_t)WS_END, n_in, n_in > 0 ? in_sizes[0] : -1, out_size, ws_size); grid = -1; return; }
        int dev = 0, cus = 0, per_cu = 0;
        if (hipGetDevice(&dev) != hipSuccess || hipDeviceGetAttribute(&cus, hipDeviceAttributeMultiprocessorCount, dev) != hipSuccess) { fprintf(stderr, "kernel_launch: hipGetDevice / hipDeviceGetAttribute failed; nothing launched\n"); grid = -1; return; }
        if (hipFuncSetAttribute((const void*)skel_fwd, hipFuncAttributeMaxDynamicSharedMemorySize, LDS_BYTES) != hipSuccess) { fprintf(stderr, "kernel_launch: hipFuncSetAttribute failed (%d bytes of dynamic LDS); nothing launched\n", LDS_BYTES); grid = -1; return; }
        if (hipOccupancyMaxActiveBlocksPerMultiprocessor(&per_cu, (const void*)skel_fwd, NWAVES * 64, LDS_BYTES) != hipSuccess || per_cu < 1)
            fprintf(stderr, "kernel_launch: note: the occupancy query reports %d workgroups per CU; launching one per CU\n", per_cu);
        (void)hipGetLastError();
        grid = cus;
    }
    if (grid < 0) return;
    if (hipMemsetAsync((char*)d_ws + WS_CTL, 0, CTL_ZERO_BYTES, stream) != hipSuccess) { fprintf(stderr, "kernel_launch: hipMemsetAsync of the control words failed; nothing launched\n"); return; }
    Args a{};
    for (int i = 0; i < N_IN; ++i) a.in[i] = (const float*)d_in[i];
    a.out = (float*)d_out; a.ws = (unsigned char*)d_ws;
#if NAIVE_MASK == 0
    a.ph_lo = 0; a.ph_hi = NPH;
    hipLaunchKernelGGL(skel_fwd, dim3(grid), dim3(NWAVES * 64), LDS_BYTES, stream, a);
    { const hipError_t le = hipPeekAtLastError(); if (le != hipSuccess) fprintf(stderr, "kernel_launch: launch failed: %s (grid %d x %d threads, %d B LDS)\n", hipGetErrorName(le), grid, NWAVES * 64, LDS_BYTES); }
#else
    for (int k = 0; k < NPH; ++k) {
        if ((NAIVE_MASK >> k) & 1 && k != 4 && k != 9) { launch_naive_phase(k, a, stream); continue; }
        a.ph_lo = k; a.ph_hi = k + 1;
        hipLaunchKernelGGL(skel_fwd, dim3(grid), dim3(NWAVES * 64), LDS_BYTES, stream, a);
        const hipError_t le = hipPeekAtLastError(); if (le != hipSuccess) { fprintf(stderr, "kernel_launch: launch of phase %d failed: %s\n", k, hipGetErrorName(le)); break; }
    }
#endif
}
```

```cpp
#include <hip/hip_runtime.h>
#include <cstdio>
#include <cstdint>

#ifndef NAIVE_MASK
#define NAIVE_MASK 0
#endif
#ifndef REPEAT_MASK
#define REPEAT_MASK 0
#endif
#ifndef STAGGER
#define STAGGER 0
#endif
#ifndef DELAY_P1_US
#define DELAY_P1_US 0
#endif
#ifndef GSP2
#define GSP2 true
#endif
#ifndef GSETPRIO
#define GSETPRIO 1
#endif
#ifndef GALIGN
#define GALIGN true
#endif
#ifndef WCOMB
#define WCOMB 1
#endif
#ifndef PROBE_EPI
#define PROBE_EPI 0
#endif
#ifndef PROBE_DUR
#define PROBE_DUR 0
#endif
#ifndef WDROP
#define WDROP 0
#endif
#ifndef X1BF16
#define X1BF16 1
#endif
#ifndef PROBE_CLK
#define PROBE_CLK 0
#endif

namespace pg8 {
#define PG8_LAS __attribute__((address_space(3)))
typedef unsigned short bf16_t;
typedef short bf16x8 __attribute__((ext_vector_type(8)));
typedef float f32x4 __attribute__((ext_vector_type(4)));
typedef unsigned u32x4 __attribute__((ext_vector_type(4)));
constexpr int BM = 256, BK = 64, HALF = 128, HTB = HALF * BK * 2  , STAGE_BYTES = 8 * HTB, NXCD = 8, WGM = 8;

__host__ __device__ __forceinline__ int lds_byte(int r, int c) { const int st = (r >> 4) * 2 + (c >> 5), rr = r & 15, cc = c & 31, ob = rr * 64 + cc * 2; return st * 1024 + (ob ^ (((ob >> 9) & 1) << 5)); }
__host__ __device__ __forceinline__ void stage_rc(int b, int& R, int& C) { const int st = b / 1024, sb = b % 1024, swz = sb ^ (((sb >> 9) & 1) << 5); R = (st >> 1) * 16 + swz / 64; C = (st & 1) * 32 + (swz % 64) / 2; }
__host__ __device__ __forceinline__ int perm32(int rho) { const int n = rho >> 4, i = rho & 15; return 8 * (i >> 2) + 4 * n + (i & 3); }

struct Unit { int pm, pn; };
struct Gemm { const bf16_t* A; const bf16_t* Bt; int lda, ldb, K; int agrp_tiles; size_t agrp_bytes; int bgrp_tiles; size_t bgrp_bytes;
    __device__ __forceinline__ size_t acol(int pn) const { return agrp_tiles ? (size_t)(pn / agrp_tiles) * agrp_bytes : (size_t)0; }
    __device__ __forceinline__ size_t bcol(int pm) const { return bgrp_tiles ? (size_t)(pm / bgrp_tiles) * bgrp_bytes : (size_t)0; } };

struct StaticOrder {
    int nM, nN, nwg, G, c;
    __host__ __device__ void init(int M, int N, int G_, int c_) { nM = M / BM; nN = N / BM; nwg = nM * nN; G = G_; c = c_; }
    __host__ __device__ bool next(int i, Unit& u) const {
        const long L = (long)i * G + c; if (L >= nwg) return false;
        int wgid = (int)L; { const int q = nwg / NXCD, r = nwg % NXCD, xcd = wgid % NXCD, off = wgid / NXCD; wgid = (xcd < r ? xcd * (q + 1) : r * (q + 1) + (xcd - r) * q) + off; }
        const int nig = WGM * nN, gid = wgid / nig, fm = gid * WGM, gsz = (nM - fm) < WGM ? (nM - fm) : WGM;
        u.pm = fm + ((wgid % nig) % gsz); u.pn = (wgid % nig) / gsz; return true;
    }
    __device__ __forceinline__ void a_ready(const Unit&) const {}
    __device__ __forceinline__ void done(const Unit&) const {}
};

__device__ __forceinline__ unsigned cvt_pk_bf16(float lo, float hi) { unsigned r; asm volatile("v_cvt_pk_bf16_f32 %0, %1, %2" : "=v"(r) : "v"(lo), "v"(hi)); return r; }
typedef float f32x2 __attribute__((ext_vector_type(2)));
__device__ __forceinline__ f32x2 gelu_pk(f32x2 v) {
    const f32x2 av = __builtin_elementwise_abs(v), d = av * 0.2316418882f + 1.0f;
    f32x2 t; t.x = __builtin_amdgcn_rcpf(d.x); t.y = __builtin_amdgcn_rcpf(d.y);
    f32x2 q = t * 0.5307027145f + (-0.7265760135f); q = q * t + 0.7107068705f; q = q * t + (-0.142248368f); q = q * t + 0.127414796f; q = q * t;
    const f32x2 s = (v * v) * (-0.72134752044f);
    f32x2 e; e.x = __builtin_amdgcn_exp2f(s.x); e.y = __builtin_amdgcn_exp2f(s.y);
    const f32x2 m = v * (q * e), r = v - m;
    f32x2 o; o.x = v.x < 0.f ? m.x : r.x; o.y = v.y < 0.f ? m.y : r.y; return o;
}

__device__ __forceinline__ float silu1(float z) { return z * __builtin_amdgcn_rcpf(1.0f + __builtin_amdgcn_exp2f(z * -1.4426950408889634f)); }
__device__ __forceinline__ f32x4 gelu4(f32x4 v) { const f32x2 a = gelu_pk((f32x2){v[0], v[1]}), b = gelu_pk((f32x2){v[2], v[3]}); return (f32x4){a.x, a.y, b.x, b.y}; }
__device__ __forceinline__ f32x4 silu4(f32x4 v) { return (f32x4){silu1(v[0]), silu1(v[1]), silu1(v[2]), silu1(v[3])}; }
__device__ __forceinline__ u32x4 pack8(f32x4 a, f32x4 b) { u32x4 w; w.x = cvt_pk_bf16(a[0], a[1]); w.y = cvt_pk_bf16(a[2], a[3]); w.z = cvt_pk_bf16(b[0], b[1]); w.w = cvt_pk_bf16(b[2], b[3]); return w; }
__device__ __forceinline__ f32x4 unpk_lo(u32x4 w) { return (f32x4){__uint_as_float(w.x << 16), __uint_as_float(w.x & 0xffff0000u), __uint_as_float(w.y << 16), __uint_as_float(w.y & 0xffff0000u)}; }
__device__ __forceinline__ f32x4 unpk_hi(u32x4 w) { return (f32x4){__uint_as_float(w.z << 16), __uint_as_float(w.z & 0xffff0000u), __uint_as_float(w.w << 16), __uint_as_float(w.w & 0xffff0000u)}; }

#ifndef EPI_NT
#define EPI_NT 0
#endif
__device__ __forceinline__ void st16(bf16_t* p, u32x4 v) { if (EPI_NT) __builtin_nontemporal_store(v, (u32x4*)p); else *(u32x4*)p = v; }
__device__ __forceinline__ float row16_sum(float v) {
    v += __builtin_bit_cast(float, __builtin_amdgcn_update_dpp(0, __builtin_bit_cast(int, v), 0x128, 0xf, 0xf, false));
    v += __builtin_bit_cast(float, __builtin_amdgcn_update_dpp(0, __builtin_bit_cast(int, v), 0x124, 0xf, 0xf, false));
    v += __builtin_bit_cast(float, __builtin_amdgcn_update_dpp(0, __builtin_bit_cast(int, v), 0x122, 0xf, 0xf, false));
    v += __builtin_bit_cast(float, __builtin_amdgcn_update_dpp(0, __builtin_bit_cast(int, v), 0x121, 0xf, 0xf, false));
    return v;
}
struct EpiPlain {
    static constexpr bool PERM = true, AFTER_DRAIN = false;
    bf16_t* O; int ldc;
    __device__ __forceinline__ void operator()(const f32x4 (&acc)[2][2][4][2], const Unit& u, int wr, int wc, int fr, int fq) const {
        const int row0 = u.pm * BM + wr * 64 + fr, col0 = u.pn * BM + wc * 32 + 8 * fq;
#pragma unroll
        for (int ai = 0; ai < 2; ++ai)
#pragma unroll
            for (int m = 0; m < 4; ++m) { bf16_t* rowp = O + (size_t)(row0 + ai * HALF + m * 16) * ldc + col0;
#pragma unroll
                for (int bj = 0; bj < 2; ++bj) st16(rowp + bj * HALF, pack8(acc[ai][bj][m][0], acc[ai][bj][m][1])); }
    }
};
struct EpiUZ {
    static constexpr bool PERM = true, AFTER_DRAIN = false;
    bf16_t* O; int ldc;
    __device__ __forceinline__ void operator()(const f32x4 (&acc)[2][2][4][2], const Unit& u, int wr, int wc, int fr, int fq) const {
        const int row0 = u.pm * BM + wr * 64 + fr, ch0 = u.pn * HALF + wc * 32 + 8 * fq;
#pragma unroll
        for (int ai = 0; ai < 2; ++ai)
#pragma unroll
            for (int m = 0; m < 4; ++m) { bf16_t* rowp = O + (size_t)(row0 + ai * HALF + m * 16) * ldc + ch0;
                const f32x4 g0 = gelu4(acc[ai][0][m][0]), g1 = gelu4(acc[ai][0][m][1]), s0 = silu4(acc[ai][1][m][0]), s1 = silu4(acc[ai][1][m][1]);
                __builtin_nontemporal_store(pack8(g0 * s0, g1 * s1), (u32x4*)rowp); }
    }
};
struct EpiGvT {
    static constexpr bool PERM = true, AFTER_DRAIN = false;
    bf16_t* O; int ldc; float* ST; int ntok;
    __device__ __forceinline__ void operator()(const f32x4 (&acc)[2][2][4][2], const Unit& u, int wr, int wc, int fr, int fq) const {
        const int ch0 = u.pm * BM + wr * 64 + fr, tok0 = u.pn * BM + wc * 32 + 8 * fq;
        f32x4 s1[2][2], s2[2][2];
#pragma unroll
        for (int bj = 0; bj < 2; ++bj)
#pragma unroll
            for (int n = 0; n < 2; ++n) { s1[bj][n] = (f32x4){0.f, 0.f, 0.f, 0.f}; s2[bj][n] = (f32x4){0.f, 0.f, 0.f, 0.f}; }
#pragma unroll
        for (int ai = 0; ai < 2; ++ai)
#pragma unroll
            for (int m = 0; m < 4; ++m) { bf16_t* rowp = O + (size_t)(ch0 + ai * HALF + m * 16) * ldc + tok0;
#pragma unroll
                for (int bj = 0; bj < 2; ++bj) { const f32x4 v0 = gelu4(acc[ai][bj][m][0]), v1 = gelu4(acc[ai][bj][m][1]);
                    s1[bj][0] += v0; s2[bj][0] += v0 * v0; s1[bj][1] += v1; s2[bj][1] += v1 * v1;
                    st16(rowp + bj * HALF, pack8(v0, v1)); } }
#pragma unroll
        for (int bj = 0; bj < 2; ++bj)
#pragma unroll
            for (int n = 0; n < 2; ++n)
#pragma unroll
                for (int e = 0; e < 4; ++e) { s1[bj][n][e] = row16_sum(s1[bj][n][e]); s2[bj][n][e] = row16_sum(s2[bj][n][e]); }
        if (fr == 0) { float* st = ST + ((size_t)(u.pm * 2 + wr) * ntok + tok0) * 2;
#pragma unroll
            for (int bj = 0; bj < 2; ++bj)
#pragma unroll
                for (int n = 0; n < 2; ++n) { float* q = st + (bj * HALF + 4 * n) * 2;
                    *(f32x4*)q = (f32x4){s1[bj][n][0], s2[bj][n][0], s1[bj][n][1], s2[bj][n][1]};
                    *(f32x4*)(q + 4) = (f32x4){s1[bj][n][2], s2[bj][n][2], s1[bj][n][3], s2[bj][n][3]}; } }
    }
};
struct EpiPZ {
    static constexpr bool PERM = true, AFTER_DRAIN = false;
    bf16_t* P; bf16_t* SZ; int ldc; int nP;
    __device__ __forceinline__ void operator()(const f32x4 (&acc)[2][2][4][2], const Unit& u, int wr, int wc, int fr, int fq) const {
        const bool isz = u.pn >= nP; bf16_t* base = isz ? SZ : P;
        const int row0 = u.pm * BM + wr * 64 + fr, col0 = (isz ? u.pn - nP : u.pn) * BM + wc * 32 + 8 * fq;
#pragma unroll
        for (int ai = 0; ai < 2; ++ai)
#pragma unroll
            for (int m = 0; m < 4; ++m) { bf16_t* rowp = base + (size_t)(row0 + ai * HALF + m * 16) * ldc + col0;
#pragma unroll
                for (int bj = 0; bj < 2; ++bj) { f32x4 v0 = acc[ai][bj][m][0], v1 = acc[ai][bj][m][1];
                    if (isz) { v0 = silu4(v0); v1 = silu4(v1); }
                    st16(rowp + bj * HALF, pack8(v0, v1)); } }
    }
};
struct EpiMix {
    static constexpr bool PERM = true, AFTER_DRAIN = false;
    const bf16_t* SZ; bf16_t* Y; int ldc; const float* bgrp; const float* scale;
    __device__ __forceinline__ void operator()(const f32x4 (&acc)[2][2][4][2], const Unit& u, int wr, int wc, int fr, int fq) const {
        const int row0 = u.pm * BM + wr * 64 + fr, ch0 = u.pn * BM + wc * 32 + 8 * fq;
        f32x4 sc[2][2], bs[2][2];
#pragma unroll
        for (int bj = 0; bj < 2; ++bj)
#pragma unroll
            for (int n = 0; n < 2; ++n) { sc[bj][n] = *(const f32x4*)(scale + ch0 + bj * HALF + 4 * n); bs[bj][n] = *(const f32x4*)(bgrp + ch0 + bj * HALF + 4 * n) * sc[bj][n]; }
#pragma unroll
        for (int ai = 0; ai < 2; ++ai) {
            u32x4 z[4][2];
#pragma unroll
            for (int m = 0; m < 4; ++m)
#pragma unroll
                for (int bj = 0; bj < 2; ++bj) z[m][bj] = *(const u32x4*)(SZ + (size_t)(row0 + ai * HALF + m * 16) * ldc + ch0 + bj * HALF);
#pragma unroll
            for (int m = 0; m < 4; ++m) { const size_t off = (size_t)(row0 + ai * HALF + m * 16) * ldc + ch0;
#pragma unroll
                for (int bj = 0; bj < 2; ++bj) {
                    const f32x4 v0 = (acc[ai][bj][m][0] * sc[bj][0] + bs[bj][0]) * unpk_lo(z[m][bj]), v1 = (acc[ai][bj][m][1] * sc[bj][1] + bs[bj][1]) * unpk_hi(z[m][bj]);
                    st16(Y + off + bj * HALF, pack8(v0, v1)); } } }
    }
};

template <class Epi, class Sched, bool ALIGN_EPI = false, bool SP2 = false, bool PROBE = false>
__device__ __forceinline__ void gemm_phase(PG8_LAS unsigned char* lds, const Gemm g, const Sched& S, const Epi& E) {
#define PG8_PSTAMP(k) do { if (PROBE && blockIdx.x == 0 && threadIdx.x == 0) ((PG8_LAS unsigned long long*)(lds + STAGE_BYTES + 1024))[k] = __builtin_amdgcn_s_memtime(); } while (0)
    const int tid = threadIdx.x, wid = __builtin_amdgcn_readfirstlane(tid >> 6), lane = tid & 63, wr = wid >> 2, wc = wid & 3, fr = lane & 15, fq = lane >> 4;
    const int K = g.K, nt = K / BK;
    unsigned voffA[2], voffB[2];
#pragma unroll
    for (int i = 0; i < 2; ++i) { int R, C; stage_rc(tid * 16 + i * 8192, R, C); const int Rb = Epi::PERM ? ((R & ~31) + perm32(R & 31)) : R;
        voffA[i] = (unsigned)(R * g.lda + C) * 2u; voffB[i] = (unsigned)(Rb * g.ldb + C) * 2u; }
    const size_t kstep = (size_t)(BK * 2);
    const size_t hstepA = (size_t)HALF * g.lda * 2, hstepB = (size_t)HALF * g.ldb * 2;
    const size_t tstepA = 2 * hstepA, tstepB = 2 * hstepB;
    const unsigned ldsw = (unsigned)wid * 1024u;
    const int aoff = lds_byte(wr * 64 + fr, fq * 8), boff = lds_byte(wc * 32 + fr, fq * 8);
#define PG8_SA(b, h) (((b) * 2 + (h)) * HTB)
#define PG8_SB(b, h) ((4 + (b) * 2 + (h)) * HTB)
#define PG8_STAGE(bufoff, gbase, voff) do { _Pragma("unroll") for (int _i = 0; _i < 2; ++_i) \
        __builtin_amdgcn_global_load_lds((const unsigned*)((const char*)(gbase) + (voff)[_i]), (PG8_LAS unsigned*)(lds + (bufoff) + ldsw + _i * 8192), 16, 0, 0); } while (0)
#define PG8_LDA(dst, b, h) do { _Pragma("unroll") for (int m = 0; m < 4; ++m) _Pragma("unroll") for (int k = 0; k < 2; ++k) dst[m][k] = *(const PG8_LAS bf16x8*)(lds + PG8_SA(b, h) + aoff + m * 2048 + k * 1024); } while (0)
#define PG8_LDB(dst, b, h) do { _Pragma("unroll") for (int n = 0; n < 2; ++n) _Pragma("unroll") for (int k = 0; k < 2; ++k) dst[n][k] = *(const PG8_LAS bf16x8*)(lds + PG8_SB(b, h) + boff + n * 2048 + k * 1024); } while (0)
#define PG8_MMA(ai, bj, At, Bt) do { if (GSETPRIO) __builtin_amdgcn_s_setprio(1); _Pragma("unroll") for (int m = 0; m < 4; ++m) _Pragma("unroll") for (int n = 0; n < 2; ++n) _Pragma("unroll") for (int k = 0; k < 2; ++k) \
        acc[ai][bj][m][n] = __builtin_amdgcn_mfma_f32_16x16x32_bf16(Bt[n][k], At[m][k], acc[ai][bj][m][n], 0, 0, 0); if (GSETPRIO) __builtin_amdgcn_s_setprio(0); } while (0)
#define PG8_WAIT_V(n) asm volatile("s_waitcnt vmcnt(" #n ")" ::: "memory")
#define PG8_WAIT_L(n) asm volatile("s_waitcnt lgkmcnt(" #n ")" ::: "memory")
#define PG8_BAR __builtin_amdgcn_s_barrier()
#define PG8_SCHED __builtin_amdgcn_sched_barrier(0)
    Unit cur, nxt; int ui = 0;
    if (!S.next(0, cur)) return;
    f32x4 acc[2][2][4][2];
#pragma unroll
    for (int a = 0; a < 2; ++a)
#pragma unroll
        for (int b = 0; b < 2; ++b)
#pragma unroll
            for (int m = 0; m < 4; ++m)
#pragma unroll
                for (int n = 0; n < 2; ++n) acc[a][b][m][n] = (f32x4){0.f, 0.f, 0.f, 0.f};
    bf16x8 At[4][2], B0[2][2], B1[2][2];
    const char* cA = (const char*)g.A + (size_t)cur.pm * tstepA + g.acol(cur.pn); const char* cB = (const char*)g.Bt + (size_t)cur.pn * tstepB + g.bcol(cur.pm);
    S.a_ready(cur);
    if constexpr (SP2) {
        PG8_STAGE(PG8_SB(0, 0), cB, voffB); PG8_STAGE(PG8_SB(0, 1), cB + hstepB, voffB); PG8_STAGE(PG8_SA(0, 0), cA, voffA); PG8_STAGE(PG8_SA(0, 1), cA + hstepA, voffA);
        if (wr == 1) PG8_BAR;
        PG8_WAIT_V(2); PG8_BAR;
        PG8_STAGE(PG8_SB(1, 0), cB + kstep, voffB); PG8_STAGE(PG8_SA(1, 0), cA + kstep, voffA); PG8_STAGE(PG8_SB(1, 1), cB + hstepB + kstep, voffB);
        PG8_WAIT_V(6); PG8_BAR;
    } else {
        PG8_STAGE(PG8_SB(0, 0), cB, voffB); PG8_STAGE(PG8_SA(0, 0), cA, voffA); PG8_STAGE(PG8_SB(0, 1), cB + hstepB, voffB); PG8_STAGE(PG8_SA(0, 1), cA + hstepA, voffA);
        if (wr == 1) PG8_BAR;
        PG8_WAIT_V(4); PG8_BAR;
        PG8_STAGE(PG8_SB(1, 0), cB + kstep, voffB); PG8_STAGE(PG8_SA(1, 0), cA + kstep, voffA); PG8_STAGE(PG8_SB(1, 1), cB + hstepB + kstep, voffB);
        PG8_WAIT_V(6); PG8_BAR;
    }
    for (;;) {
        const bool has_next = S.next(ui + 1, nxt);
        const char* nA = has_next ? (const char*)g.A + (size_t)nxt.pm * tstepA + g.acol(nxt.pn) : cA; const char* nB = has_next ? (const char*)g.Bt + (size_t)nxt.pn * tstepB + g.bcol(nxt.pm) : cB;
        for (int t = 0; t < nt; t += 2) {
            const bool last = (t == nt - 2);
            const char* a1 = cA + (size_t)(t + 1) * kstep;
            const char* a2 = last ? nA : cA + (size_t)(t + 2) * kstep; const char* b2 = last ? nB : cB + (size_t)(t + 2) * kstep;
            const char* a3 = a2 + kstep; const char* b3 = b2 + kstep;
            if (last && has_next) S.a_ready(nxt);
            if constexpr (SP2) {
            PG8_LDB(B0, 0, 0); PG8_LDB(B1, 0, 1); PG8_SCHED; PG8_LDA(At, 0, 0); PG8_STAGE(PG8_SA(1, 1), a1 + hstepA, voffA);
            PG8_WAIT_V(8); PG8_WAIT_L(0); PG8_BAR; if (PROBE && t == 0 && ui == 2) PG8_PSTAMP(2); PG8_MMA(0, 0, At, B0); PG8_MMA(0, 1, At, B1); PG8_BAR; PG8_SCHED;
            PG8_LDA(At, 0, 1); PG8_STAGE(PG8_SB(0, 0), b2, voffB); PG8_STAGE(PG8_SB(0, 1), b2 + hstepB, voffB); PG8_STAGE(PG8_SA(0, 0), a2, voffA);
            PG8_WAIT_V(8); PG8_WAIT_L(0); PG8_BAR; PG8_MMA(1, 0, At, B0); PG8_MMA(1, 1, At, B1); PG8_BAR; PG8_SCHED;
            PG8_LDB(B0, 1, 0); PG8_LDB(B1, 1, 1); PG8_SCHED; PG8_LDA(At, 1, 0); PG8_STAGE(PG8_SA(0, 1), a2 + hstepA, voffA);
            PG8_WAIT_V(8); PG8_WAIT_L(0); PG8_BAR; PG8_MMA(0, 0, At, B0); PG8_MMA(0, 1, At, B1); PG8_BAR; PG8_SCHED;
            PG8_LDA(At, 1, 1); PG8_STAGE(PG8_SB(1, 0), b3, voffB); PG8_STAGE(PG8_SB(1, 1), b3 + hstepB, voffB); PG8_STAGE(PG8_SA(1, 0), a3, voffA);
            PG8_WAIT_V(8); PG8_WAIT_L(0); PG8_BAR; PG8_MMA(1, 0, At, B0); PG8_MMA(1, 1, At, B1); PG8_BAR; PG8_SCHED;
            } else {
            PG8_LDB(B0, 0, 0); PG8_SCHED; PG8_LDA(At, 0, 0); PG8_STAGE(PG8_SA(1, 1), a1 + hstepA, voffA);
            PG8_WAIT_L(8); PG8_BAR; PG8_WAIT_L(0); PG8_MMA(0, 0, At, B0); PG8_BAR; PG8_SCHED;
            PG8_LDB(B1, 0, 1); PG8_STAGE(PG8_SB(0, 0), b2, voffB);
            PG8_BAR; PG8_WAIT_L(0); PG8_MMA(0, 1, At, B1); PG8_BAR;
            PG8_LDA(At, 0, 1); PG8_STAGE(PG8_SA(0, 0), a2, voffA);
            PG8_BAR; PG8_WAIT_L(0); PG8_MMA(1, 0, At, B0); PG8_BAR; PG8_SCHED;
            PG8_STAGE(PG8_SB(0, 1), b2 + hstepB, voffB);
            PG8_WAIT_V(6); PG8_BAR; PG8_MMA(1, 1, At, B1); PG8_BAR;
            PG8_LDB(B0, 1, 0); PG8_SCHED; PG8_LDA(At, 1, 0); PG8_STAGE(PG8_SA(0, 1), a2 + hstepA, voffA);
            PG8_WAIT_L(8); PG8_BAR; PG8_WAIT_L(0); PG8_MMA(0, 0, At, B0); PG8_BAR; PG8_SCHED;
            PG8_LDB(B1, 1, 1); PG8_STAGE(PG8_SB(1, 0), b3, voffB);
            PG8_BAR; PG8_WAIT_L(0); PG8_MMA(0, 1, At, B1); PG8_BAR;
            PG8_LDA(At, 1, 1); PG8_STAGE(PG8_SA(1, 0), a3, voffA);
            PG8_BAR; PG8_WAIT_L(0); PG8_MMA(1, 0, At, B0); PG8_BAR; PG8_SCHED;
            PG8_STAGE(PG8_SB(1, 1), b3 + hstepB, voffB);
            PG8_WAIT_V(6); PG8_BAR; PG8_MMA(1, 1, At, B1); PG8_BAR;
            }
        }
        if (PROBE && ui == 1) PG8_PSTAMP(0); if (PROBE && ui == 2) PG8_PSTAMP(3);
        if constexpr (ALIGN_EPI) { if (wr == 0) PG8_BAR; }
        if constexpr (!Epi::AFTER_DRAIN) { E(acc, cur, wr, wc, fr, fq); S.done(cur); }
        if (PROBE && ui == 1) PG8_PSTAMP(1); if (PROBE && ui == 2) PG8_PSTAMP(4);
        if (!has_next) break;
#pragma unroll
        for (int a = 0; a < 2; ++a)
#pragma unroll
            for (int b = 0; b < 2; ++b)
#pragma unroll
                for (int m = 0; m < 4; ++m)
#pragma unroll
                    for (int n = 0; n < 2; ++n) acc[a][b][m][n] = (f32x4){0.f, 0.f, 0.f, 0.f};
        cur = nxt; cA = nA; cB = nB; ++ui;
        if constexpr (ALIGN_EPI) { if (wr == 1) PG8_BAR; }
    }
    PG8_WAIT_V(0);
    if constexpr (!ALIGN_EPI) { if (wr == 0) PG8_BAR; }
    PG8_BAR;
    if constexpr (Epi::AFTER_DRAIN) { E.fused(acc, cur, wr, wc, fr, fq, lds, wid, lane); S.done(cur); }
#undef PG8_PSTAMP
#undef PG8_SA
#undef PG8_SB
#undef PG8_STAGE
#undef PG8_LDA
#undef PG8_LDB
#undef PG8_MMA
#undef PG8_WAIT_V
#undef PG8_WAIT_L
#undef PG8_BAR
#undef PG8_SCHED
}
}

constexpr int NWAVES = 8;
constexpr int DM = 4096, EI = 8192, BATCH = 4, SEQ = 2048, MTOK = BATCH * SEQ;
constexpr int CHUNK = 128, NHEAD = 16, HDIM = EI / NHEAD;
constexpr int NGRP = 4, GWID = EI / NGRP;
constexpr float EPS = 1e-6f;
constexpr int NST = 64;
constexpr int NPH = 10;
static_assert(MTOK % 256 == 0 && SEQ % CHUNK == 0 && SEQ % 256 == 0, "tiling");

constexpr size_t MiB = 1u << 20;
constexpr size_t WS_CTL = 0, CTL_ZERO_BYTES = 64 * 1024;
constexpr size_t WS_W1UZ = 1 * MiB;
constexpr size_t WS_W1V  = WS_W1UZ + (size_t)2 * EI * DM * 2;
constexpr size_t WS_W2   = WS_W1V + (size_t)EI * DM * 2;
constexpr size_t WS_W3   = WS_W2 + (size_t)DM * EI * 2;
constexpr size_t WS_W4   = WS_W3 + (size_t)2 * EI * DM * 2;
constexpr size_t WS_W5   = WS_W4 + (size_t)EI * GWID * 2;
constexpr size_t WS_H    = WS_W5 + (size_t)DM * EI * 2;
constexpr size_t WS_B0   = WS_H + (size_t)MTOK * DM * 2;
constexpr size_t WS_B1   = WS_B0 + (size_t)MTOK * EI * 2;
constexpr size_t WS_B2   = WS_B1 + (size_t)MTOK * EI * 2;
constexpr size_t WS_M    = WS_B2 + (size_t)MTOK * EI * 2;
constexpr size_t WS_ST   = WS_M + (size_t)MTOK * DM * 2;
constexpr size_t WS_DBG  = WS_ST + (size_t)NST * MTOK * 8;
constexpr size_t WS_X1B  = WS_DBG + (size_t)MTOK * 8;
constexpr size_t WS_END  = WS_X1B + (size_t)MTOK * DM * 2;
constexpr size_t WS_W3P = WS_W3 + (size_t)EI * DM * 2;
constexpr size_t WS_WC = WS_W1V, WS_Y1 = WS_W1UZ, WS_PH = WS_B1;
static_assert(WS_B2 == WS_B1 + (size_t)MTOK * EI * 2 && (size_t)NGRP * MTOK * DM * 2 <= 2 * (size_t)MTOK * EI * 2, "PH overlays B1|B2");
constexpr int CW_BAR = 4096;

constexpr int RING_OFF = 0, RING_BYTES = 131072;
constexpr int LDSCTL_OFF = RING_BYTES, MISC_OFF = LDSCTL_OFF + 320;
constexpr int LDS_BYTES = 147456;
static_assert(MISC_OFF + 128 <= LDS_BYTES, "LDS map");

#define GAS __attribute__((address_space(1)))
#define LAS __attribute__((address_space(3)))
typedef unsigned short bf16;
typedef unsigned v4u __attribute__((ext_vector_type(4)));
typedef float f32x4 __attribute__((ext_vector_type(4)));
typedef short bf16x8 __attribute__((ext_vector_type(8)));
typedef GAS unsigned gu32;
typedef GAS unsigned long long gu64;
#define RLX_AGENT __ATOMIC_RELAXED, __HIP_MEMORY_SCOPE_AGENT
#define LDS_WAIT() asm volatile("s_waitcnt lgkmcnt(0)" ::: "memory")
#define VM_WAIT() asm volatile("s_waitcnt vmcnt(0)" ::: "memory")
__device__ __forceinline__ unsigned long long rt() { return __builtin_amdgcn_s_memrealtime(); }
__device__ __forceinline__ unsigned f2bf(float f) { unsigned u = __builtin_bit_cast(unsigned, f); return (u + 0x7fffu + ((u >> 16) & 1u)) >> 16; }
__device__ __forceinline__ unsigned pk2(float lo, float hi) { return f2bf(lo) | (f2bf(hi) << 16); }

#define XB_TMO      128
#define XB_XCNT(j)  (256  + 64 * (j))
#define XB_XSUB(j)  (1280 + 64 * (j))
#define XB_XGEN(j)  (2304 + 64 * (j))
#define XB_TOP      3328
#define XB_TOPGEN   3392
#define XCD_BAR_WORDS 3456
#define XB_SPIN_CAP (1u << 18)

__device__ __forceinline__ unsigned xb_ld(unsigned* p)              { return __hip_atomic_load(p, __ATOMIC_RELAXED, __HIP_MEMORY_SCOPE_AGENT); }
__device__ __forceinline__ unsigned xb_add(unsigned* p, unsigned v) { return __hip_atomic_fetch_add(p, v, __ATOMIC_RELAXED, __HIP_MEMORY_SCOPE_AGENT); }
__device__ __forceinline__ unsigned xb_xcc_id() { return (unsigned)__builtin_amdgcn_s_getreg((3 << 11) | 20) & 0xFu; }
#define XB_SPIN(cond, bar) do { unsigned _sp = 0; while (cond) { __builtin_amdgcn_s_sleep(1); \
    if ((++_sp & 255u) == 0u) { if (xb_ld(&(bar)[XB_TMO])) break; if (_sp > XB_SPIN_CAP) { atomicAdd(&(bar)[XB_TMO], 1u); break; } } } } while (0)

struct XcdBarrier {
    unsigned* bar; unsigned x;
    volatile LAS unsigned* st;
};

__device__ __forceinline__ XcdBarrier xcd_barrier_post(unsigned* bar, volatile LAS unsigned* st) {
    XcdBarrier b; b.bar = bar; b.x = xb_xcc_id(); b.st = st;
    if (threadIdx.x == 0) (void)xb_add(&bar[XB_XCNT(b.x)], 1u);
    return b;
}
__device__ __forceinline__ void xcd_barrier_complete(unsigned* bar, unsigned x, unsigned& nloc, unsigned& nx) {
    const unsigned G = gridDim.x * gridDim.y * gridDim.z;
    unsigned sum, cnt, mine, sp = 0u;
    for (;;) {
        sum = 0u; cnt = 0u; mine = 0u;
#pragma unroll
        for (unsigned j = 0; j < 16; ++j) { const unsigned c = xb_ld(&bar[XB_XCNT(j)]); sum += c; cnt += (c > 0u) ? 1u : 0u; mine = (j == x) ? c : mine; }
        if (sum == G) break;
        __builtin_amdgcn_s_sleep(1);
        if ((++sp & 255u) == 0u) { if (xb_ld(&bar[XB_TMO])) break; if (sp > XB_SPIN_CAP) { atomicAdd(&bar[XB_TMO], 1u); break; } }
    }
    nloc = mine > 0u ? mine : 1u; nx = cnt > 0u ? cnt : 1u;
}

__device__ __forceinline__ void xcd_barrier(const XcdBarrier& b) {
    asm volatile("s_waitcnt vmcnt(0)" ::: "memory");
    __syncthreads();
    if (threadIdx.x == 0) {
        unsigned* bar = b.bar;
        __builtin_amdgcn_s_waitcnt(0);
        unsigned nloc = b.st[0], nx = b.st[1];
        if (nloc == 0u) { xcd_barrier_complete(bar, b.x, nloc, nx); b.st[0] = nloc; b.st[1] = nx; }
        const unsigned old = xb_add(&bar[XB_XSUB(b.x)], 1u);
        const unsigned gen = old / nloc;
        if (old + 1u == (gen + 1u) * nloc) {
            __builtin_amdgcn_fence(__ATOMIC_RELEASE, "agent");
            asm volatile("s_waitcnt vmcnt(0)" ::: "memory");
            const unsigned og = xb_add(&bar[XB_TOP], 1u);
            const unsigned tg = og / nx;
            if (og + 1u == (tg + 1u) * nx) xb_add(&bar[XB_TOPGEN], 1u);
            else XB_SPIN(xb_ld(&bar[XB_TOPGEN]) == tg, bar);
            __builtin_amdgcn_fence(__ATOMIC_ACQUIRE, "agent");
            xb_add(&bar[XB_XGEN(b.x)], 1u);
            asm volatile("s_waitcnt vmcnt(0)" ::: "memory");
        } else {
            XB_SPIN(xb_ld(&bar[XB_XGEN(b.x)]) == gen, bar);
            __builtin_amdgcn_fence(__ATOMIC_ACQUIRE, "agent");
            asm volatile("s_waitcnt vmcnt(0)" ::: "memory");
        }
    }
    __syncthreads();
}

enum { IN_X = 0, IN_PRE, IN_POST, IN_AWIN, IN_ALNG, IN_ALNB, IN_AWS, IN_ABS, IN_AWOUT, IN_BWIN, IN_BWGRP, IN_BBGRP, IN_BSCALE, IN_BWOUT, N_IN };
struct Args { const float* in[N_IN]; float* out; unsigned char* ws; int ph_lo, ph_hi; };
struct Frame {
    LAS unsigned char* lds;
    volatile LAS unsigned* MISC;
    gu32* ctl;
    int tid, lane, wave;
    int vcu, G;
};
__device__ __forceinline__ float wave_sum(float v) {
#pragma unroll
    for (int o = 1; o < 64; o <<= 1) v += __shfl_xor(v, o);
    return v;
}
__device__ __forceinline__ float dot4(f32x4 a, f32x4 b) { return (a.x * b.x + a.y * b.y) + (a.z * b.z + a.w * b.w); }
using pg8::cvt_pk_bf16; using pg8::pack8; using pg8::unpk_lo; using pg8::unpk_hi; using pg8::u32x4; using pg8::f32x2;

struct CvDesc { const float* src; bf16* dst; int ldw, K, plain; };
__device__ __forceinline__ CvDesc cv_make(const float* W, int ldw, int K, int n0, bf16* WT, int drow0, int k0, int lane) {
    const int kq = lane & 7, nq = lane >> 3; CvDesc d; d.src = W + (size_t)(k0 + 8 * kq) * ldw + n0 + 4 * nq; d.dst = WT + (size_t)(drow0 + 4 * nq) * K + k0 + 8 * kq; d.ldw = ldw; d.K = K; d.plain = 0; return d; }
__device__ __forceinline__ CvDesc cv_make_plain(const float* W, int ldw, bf16* D, int ldd, int row0, int col0, int lane) {
    CvDesc d; d.src = W + (size_t)row0 * ldw + col0 + 8 * lane; d.dst = D + (size_t)row0 * ldd + col0 + 8 * lane; d.ldw = ldw; d.K = ldd; d.plain = 1; return d; }
__device__ __forceinline__ void cv_load(const CvDesc& d, f32x4 (&r)[8]) {
    const GAS f32x4* src = (const GAS f32x4*)d.src;
    if (d.plain) {
#pragma unroll
        for (int j = 0; j < 4; ++j) { r[2 * j] = __builtin_nontemporal_load(src + (size_t)j * (d.ldw / 4)); r[2 * j + 1] = __builtin_nontemporal_load(src + (size_t)j * (d.ldw / 4) + 1); }
    } else {
#pragma unroll
        for (int j = 0; j < 8; ++j) r[j] = __builtin_nontemporal_load(src + (size_t)j * (d.ldw / 4));
    }
}
__device__ __forceinline__ unsigned wq(unsigned w) { if (WDROP == 0) return w; constexpr unsigned h = (1u << (WDROP > 0 ? WDROP - 1 : 0)) * 0x00010001u, m = ~(((1u << WDROP) - 1u) * 0x00010001u); return (w + h) & m; }
__device__ __forceinline__ v4u wq4(v4u o) { o.x = wq(o.x); o.y = wq(o.y); o.z = wq(o.z); o.w = wq(o.w); return o; }
__device__ __forceinline__ void cv_store(const CvDesc& d, const f32x4 (&r)[8]) {
    if (d.plain) {
#pragma unroll
        for (int j = 0; j < 4; ++j) __builtin_nontemporal_store(wq4(pack8(r[2 * j], r[2 * j + 1])), (GAS v4u*)(d.dst + (size_t)j * d.K));
    } else {
#pragma unroll
        for (int e = 0; e < 4; ++e) { v4u o; o.x = cvt_pk_bf16(r[0][e], r[1][e]); o.y = cvt_pk_bf16(r[2][e], r[3][e]); o.z = cvt_pk_bf16(r[4][e], r[5][e]); o.w = cvt_pk_bf16(r[6][e], r[7][e]);
            __builtin_nontemporal_store(wq4(o), (GAS v4u*)(d.dst + (size_t)e * d.K)); }
    }
}
__device__ __forceinline__ void rms_row_to_bf16(const float* xrow, const float* g, bf16* orow, int lane) {
    const GAS f32x4* xr = (const GAS f32x4*)xrow + lane;
    f32x4 v[16]; float s = 0.f;
#pragma unroll
    for (int j = 0; j < 16; ++j) { v[j] = xr[64 * j]; s += dot4(v[j], v[j]); }
    const float rstd = 1.f / sqrtf(wave_sum(s) * (1.f / DM) + EPS);
    const GAS f32x4* gr = (const GAS f32x4*)g + lane;
    GAS unsigned long long* o8 = (GAS unsigned long long*)orow + lane;
#pragma unroll
    for (int j = 0; j < 16; ++j) { const f32x4 o = v[j] * rstd * gr[64 * j];
        o8[64 * j] = (unsigned long long)cvt_pk_bf16(o.x, o.y) | ((unsigned long long)cvt_pk_bf16(o.z, o.w) << 32); }
}
constexpr int CI0 = (DM / 64) * (2 * EI / 32), CI1 = (DM / 64) * (EI / 32), CI2 = (EI / 64) * (DM / 32), CI3 = (DM / 64) * (2 * EI / 32)  , CI4G = (GWID / 64) * (GWID / 32), CI4 = NGRP * CI4G, CI5 = CI2;
constexpr int CSET_A = 0, CNT_A = CI0 + CI1, CSET_B = CNT_A, CNT_B = CI2 + CI3, CSET_C = CSET_B + CNT_B, CNT_C = CI4 + CI5;
__device__ __forceinline__ CvDesc conv_desc(const Args& a, int it, int lane) {
    int r = it;
    if (r < CI0) { constexpr int nbk = 2 * EI / 32; const int kb = r / nbk, nb = r % nbk, t = nb >> 3, jb = nb & 7;
        const int n0 = (jb < 4) ? 128 * t + 32 * jb : 2 * EI + 128 * t + 32 * (jb - 4);
        return cv_make(a.in[IN_AWIN], 3 * EI, DM, n0, (bf16*)(a.ws + WS_W1UZ), 32 * nb, 64 * kb, lane); } r -= CI0;
    if (r < CI1) { constexpr int nbk = EI / 32; const int kb = r / nbk, nb = r % nbk;
        return cv_make(a.in[IN_AWIN], 3 * EI, DM, EI + 32 * nb, (bf16*)(a.ws + WS_W1V), 32 * nb, 64 * kb, lane); } r -= CI1;
    if (r < CI2) { constexpr int nbk = DM / 32; const int kb = r / nbk, nb = r % nbk;
        return cv_make(a.in[IN_AWOUT], DM, EI, 32 * nb, (bf16*)(a.ws + WS_W2), 32 * nb, 64 * kb, lane); } r -= CI2;
#if WCOMB
    if (r < CI3 / 2) { constexpr int nbk = EI / 32; const int kb = r / nbk, nb = r % nbk;
        return cv_make(a.in[IN_BWIN], 2 * EI, DM, EI + 32 * nb, (bf16*)(a.ws + WS_W3), 32 * nb, 64 * kb, lane); }
    if (r < CI3) { r -= CI3 / 2; constexpr int nseg = EI / 512; const int rq = r / nseg, sg = r % nseg;
        return cv_make_plain(a.in[IN_BWIN], 2 * EI, (bf16*)(a.ws + WS_W3P), EI, 4 * rq, 512 * sg, lane); } r -= CI3;
#else
    if (r < CI3) { constexpr int nbk = 2 * EI / 32; const int kb = r / nbk, nb = r % nbk;
        return cv_make(a.in[IN_BWIN], 2 * EI, DM, 32 * nb, (bf16*)(a.ws + WS_W3), 32 * nb, 64 * kb, lane); } r -= CI3;
#endif
    if (r < CI4) { constexpr int nbk = GWID / 32; const int g = r / CI4G; r -= g * CI4G; const int kb = r / nbk, nb = r % nbk;
        return cv_make(a.in[IN_BWGRP] + (size_t)g * GWID * GWID, GWID, GWID, 32 * nb, (bf16*)(a.ws + WS_W4) + (size_t)g * GWID * GWID, 32 * nb, 64 * kb, lane); } r -= CI4;
    { constexpr int nbk = DM / 32; const int kb = r / nbk, nb = r % nbk;
        return cv_make(a.in[IN_BWOUT], DM, EI, 32 * nb, (bf16*)(a.ws + WS_W5), 32 * nb, 64 * kb, lane); }
}
__device__ __forceinline__ void conv_rounds(const Args& a, Frame& F, int base, int count, int i_lo, int i_hi, bool rev = false) {
    const int gw = F.vcu * NWAVES + F.wave, NGW = F.G * NWAVES;
    int i = i_lo;
    if (i + 1 < i_hi && gw + (i + 1) * NGW < count) {
        CvDesc d0 = conv_desc(a, base + (rev ? count - 1 - (gw + i * NGW) : gw + i * NGW), F.lane), d1 = conv_desc(a, base + (rev ? count - 1 - (gw + (i + 1) * NGW) : gw + (i + 1) * NGW), F.lane);
        f32x4 r0[8], r1[8]; cv_load(d0, r0); cv_load(d1, r1); i += 2;
        for (; i + 1 < i_hi && gw + (i + 1) * NGW < count; i += 2) {
            const CvDesc e0 = conv_desc(a, base + (rev ? count - 1 - (gw + i * NGW) : gw + i * NGW), F.lane), e1 = conv_desc(a, base + (rev ? count - 1 - (gw + (i + 1) * NGW) : gw + (i + 1) * NGW), F.lane);
            f32x4 q0[8], q1[8]; cv_load(e0, q0); cv_load(e1, q1);
            cv_store(d0, r0); cv_store(d1, r1);
            d0 = e0; d1 = e1;
#pragma unroll
            for (int j = 0; j < 8; ++j) { r0[j] = q0[j]; r1[j] = q1[j]; }
        }
        cv_store(d0, r0); cv_store(d1, r1);
    }
    for (; i < i_hi; ++i) { const int it = gw + i * NGW; if (it < count) { const CvDesc d = conv_desc(a, base + (rev ? count - 1 - it : it), F.lane); f32x4 r[8]; cv_load(d, r); cv_store(d, r); } }
}
__device__ __forceinline__ int conv_nrounds(const Frame& F, int count) { const int NGW = F.G * NWAVES; return (count + NGW - 1) / NGW; }
__device__ __forceinline__ int conv_npre(const Frame& F, int count) { return (int)(((long)blockIdx.x * conv_nrounds(F, count)) / F.G); }
__device__ __forceinline__ void p0_prologue(const Args& a, Frame& F) {
    const int gw = F.vcu * NWAVES + F.wave, NGW = F.G * NWAVES, lane = F.lane;
#if !STAGGER
    conv_rounds(a, F, CSET_A, CNT_A + CNT_B + CNT_C, 0, conv_nrounds(F, CNT_A + CNT_B + CNT_C), true);
#else
    conv_rounds(a, F, CSET_A, CNT_A, 0, conv_nrounds(F, CNT_A));
#endif
    for (int m = gw; m < MTOK; m += NGW) rms_row_to_bf16(a.in[IN_X] + (size_t)m * DM, a.in[IN_PRE], (bf16*)(a.ws + WS_H) + (size_t)m * DM, lane);
}

__device__ __forceinline__ void sgu_phase(const Args& a, Frame& F) {
    constexpr int WP_PITCH = 272, WP_BYTES = 128 * WP_PITCH;
    constexpr int OFF_CV = 2 * WP_BYTES, OFF_MU = OFF_CV + 2 * 3 * 128 * 4, OFF_RS = OFF_MU + 512, OFF_PART = OFF_RS + 512, OFF_GB = OFF_PART + 4096;
    static_assert(OFF_GB + 2 * 2 * HDIM * 4 <= RING_BYTES, "sgu LDS");
    LAS unsigned char* L = F.lds + RING_OFF;
    LAS float* MU = (LAS float*)(L + OFF_MU); LAS float* RS = (LAS float*)(L + OFF_RS); LAS float* PART = (LAS float*)(L + OFF_PART);
    const float* ST = (const float*)(a.ws + WS_ST); const bf16* GVT = (const bf16*)(a.ws + WS_B1); const bf16* UZ = (const bf16*)(a.ws + WS_B0); bf16* Y = (bf16*)(a.ws + WS_B2);
    const float* lng = a.in[IN_ALNG]; const float* lnb = a.in[IN_ALNB]; const float* wsp = a.in[IN_AWS]; const float* bsv = a.in[IN_ABS];
    const int tid = F.tid, lane = F.lane, wave = F.wave, fr = lane & 15, fq = lane >> 4;
    for (int unit = blockIdx.x; unit < (MTOK / CHUNK) * 4; unit += F.G) {
        const int ck = unit >> 2, hg = unit & 3, R0 = ck * CHUNK;
        { const int r = tid & 127, q = tid >> 7; float s = 0.f, ss = 0.f;
#pragma unroll
            for (int j = 0; j < NST / 4; ++j) { const f32x2 p = *(const GAS f32x2*)(ST + ((size_t)(q * (NST / 4) + j) * MTOK + R0 + r) * 2); s += p.x; ss += p.y; }
            PART[(q * 128 + r) * 2] = s; PART[(q * 128 + r) * 2 + 1] = ss; }
        __syncthreads();
        if (tid < 128) { float s = 0.f, ss = 0.f;
#pragma unroll
            for (int q = 0; q < 4; ++q) { s += PART[(q * 128 + tid) * 2]; ss += PART[(q * 128 + tid) * 2 + 1]; }
            const float mean = s * (1.f / EI); float var = ss * (1.f / EI) - mean * mean; var = var > 0.f ? var : 0.f;
            MU[tid] = mean; RS[tid] = 1.f / sqrtf(var + EPS); }
        __syncthreads();
        for (int hh = 0; hh < 4; ++hh) {
            const int h = hg * 4 + hh, buf = hh & 1;
            LAS unsigned char* WP = L + buf * WP_BYTES; LAS float* CV = (LAS float*)(L + OFF_CV) + buf * 384;
            { const int t = tid >> 2, part = tid & 3, s0 = 32 * part;
                const GAS f32x4* wrow = (const GAS f32x4*)(wsp + ((size_t)h * CHUNK + t) * CHUNK + s0);
                float c1 = 0.f, c2 = 0.f;
#pragma unroll
                for (int i = 0; i < 4; ++i) {
                    const f32x4 wa = wrow[2 * i], wb = wrow[2 * i + 1];
                    const f32x4 ra = *(const LAS f32x4*)(RS + s0 + 8 * i), rb = *(const LAS f32x4*)(RS + s0 + 8 * i + 4);
                    const f32x4 ma = *(const LAS f32x4*)(MU + s0 + 8 * i), mb = *(const LAS f32x4*)(MU + s0 + 8 * i + 4);
                    f32x4 ca, cb;
#pragma unroll
                    for (int e = 0; e < 4; ++e) { ca[e] = (s0 + 8 * i + e <= t) ? wa[e] : 0.f; cb[e] = (s0 + 8 * i + 4 + e <= t) ? wb[e] : 0.f; }
                    c2 += (ca.x + ca.y) + (ca.z + ca.w) + (cb.x + cb.y) + (cb.z + cb.w);
                    const u32x4 pk = pack8(ca * ra, cb * rb);
                    c1 += dot4(unpk_lo(pk), ma) + dot4(unpk_hi(pk), mb);
                    *(LAS u32x4*)(WP + t * WP_PITCH + (s0 + 8 * i) * 2) = pk; }
                c1 += __shfl_xor(c1, 1); c1 += __shfl_xor(c1, 2); c2 += __shfl_xor(c2, 1); c2 += __shfl_xor(c2, 2);
                if (part == 0) { CV[t] = c1; CV[128 + t] = c2; CV[256 + t] = bsv[h * CHUNK + t]; }
                LAS float* GB = (LAS float*)(L + OFF_GB) + buf * 2 * HDIM; GB[tid] = lng[h * HDIM + tid]; GB[HDIM + tid] = lnb[h * HDIM + tid]; }
            __syncthreads();
            const int chb = h * HDIM + wave * 64;
            bf16x8 Gf[4][4];
#pragma unroll
            for (int nd = 0; nd < 4; ++nd) { const int ch = chb + 32 * (nd >> 1) + 8 * (fr >> 2) + 4 * (nd & 1) + (fr & 3);
#pragma unroll
                for (int ks = 0; ks < 4; ++ks) Gf[nd][ks] = *(const GAS bf16x8*)(GVT + (size_t)ch * MTOK + R0 + 32 * ks + 8 * fq); }
            const LAS float* GBw = (const LAS float*)(L + OFF_GB) + buf * 2 * HDIM + wave * 64 + 8 * fq;
#pragma unroll 1
            for (int th = 0; th < 2; ++th) {
                u32x4 uzv[4][2];
#pragma unroll
                for (int mq = 0; mq < 4; ++mq)
#pragma unroll
                    for (int p = 0; p < 2; ++p) uzv[mq][p] = *(const GAS u32x4*)(UZ + (size_t)(R0 + 16 * (4 * th + mq) + fr) * EI + chb + 32 * p + 8 * fq);
                f32x4 acc[4][4];
#pragma unroll
                for (int nd = 0; nd < 4; ++nd)
#pragma unroll
                    for (int mq = 0; mq < 4; ++mq) acc[nd][mq] = (f32x4){0.f, 0.f, 0.f, 0.f};
#pragma unroll
                for (int mq = 0; mq < 4; ++mq) { const int mt = 4 * th + mq;
#pragma unroll
                    for (int ks = 0; ks < 4; ++ks) if (ks <= mt / 2) {
                        const bf16x8 wf = *(const LAS bf16x8*)(WP + (16 * mt + fr) * WP_PITCH + (32 * ks + 8 * fq) * 2);
#pragma unroll
                        for (int nd = 0; nd < 4; ++nd) acc[nd][mq] = __builtin_amdgcn_mfma_f32_16x16x32_bf16(Gf[nd][ks], wf, acc[nd][mq], 0, 0, 0); } }
#pragma unroll
                for (int mq = 0; mq < 4; ++mq) { const int t = 16 * (4 * th + mq) + fr; const float c1 = CV[t], c2 = CV[128 + t], bs = CV[256 + t];
#pragma unroll
                    for (int p = 0; p < 2; ++p) { const size_t off = (size_t)(R0 + t) * EI + chb + 32 * p + 8 * fq;
                        const u32x4 uz = uzv[mq][p];
                        const f32x4 lg0 = *(const LAS f32x4*)(GBw + 32 * p), lg1 = *(const LAS f32x4*)(GBw + 32 * p + 4), lb0 = *(const LAS f32x4*)(GBw + HDIM + 32 * p), lb1 = *(const LAS f32x4*)(GBw + HDIM + 32 * p + 4);
                        const f32x4 sv0 = lg0 * (acc[2 * p][mq] - c1) + (lb0 * c2 + bs), sv1 = lg1 * (acc[2 * p + 1][mq] - c1) + (lb1 * c2 + bs);
                        *(GAS u32x4*)(Y + off) = pack8(unpk_lo(uz) * sv0, unpk_hi(uz) * sv1); } }
            }
        }
        __syncthreads();
    }
}

template <bool FINAL>
__device__ __forceinline__ void norm_phase(const bf16* M, const float* xin, float* xout, const float* gpost, const float* gpre, bf16* H, bf16* x1b, Frame& F) {
    const int gw = F.vcu * NWAVES + F.wave, NGW = F.G * NWAVES, lane = F.lane;
    for (int m = gw; m < MTOK; m += NGW) {
        const GAS u32x4* mr = (const GAS u32x4*)(M + (size_t)m * DM) + lane;
        u32x4 mv[8]; float ss = 0.f;
#pragma unroll
        for (int j = 0; j < 8; ++j) { mv[j] = mr[64 * j]; const f32x4 lo = unpk_lo(mv[j]), hi = unpk_hi(mv[j]); ss += dot4(lo, lo) + dot4(hi, hi); }
        const float rm = 1.f / sqrtf(wave_sum(ss) * (1.f / DM) + EPS);
        f32x4 x1[16]; float s2 = 0.f;
#pragma unroll
        for (int j = 0; j < 8; ++j) { const size_t e0 = (size_t)8 * (lane + 64 * j);
            f32x4 xa, xb;
            if (FINAL && x1b) { const u32x4 xp = *(const GAS u32x4*)(x1b + (size_t)m * DM + e0); xa = unpk_lo(xp); xb = unpk_hi(xp); }
            else { xa = *(const GAS f32x4*)(xin + (size_t)m * DM + e0); xb = *(const GAS f32x4*)(xin + (size_t)m * DM + e0 + 4); }
            const f32x4 ga = *(const GAS f32x4*)(gpost + e0), gb = *(const GAS f32x4*)(gpost + e0 + 4);
            x1[2 * j] = xa + unpk_lo(mv[j]) * rm * ga; x1[2 * j + 1] = xb + unpk_hi(mv[j]) * rm * gb;
            if (!FINAL && x1b) { const u32x4 xp = pack8(x1[2 * j], x1[2 * j + 1]); *(GAS u32x4*)(x1b + (size_t)m * DM + e0) = xp; x1[2 * j] = unpk_lo(xp); x1[2 * j + 1] = unpk_hi(xp); }
            else { *(GAS f32x4*)(xout + (size_t)m * DM + e0) = x1[2 * j]; *(GAS f32x4*)(xout + (size_t)m * DM + e0 + 4) = x1[2 * j + 1]; }
            s2 += dot4(x1[2 * j], x1[2 * j]) + dot4(x1[2 * j + 1], x1[2 * j + 1]); }
        if constexpr (!FINAL) {
            const float rx = 1.f / sqrtf(wave_sum(s2) * (1.f / DM) + EPS);
#pragma unroll
            for (int j = 0; j < 8; ++j) { const size_t e0 = (size_t)8 * (lane + 64 * j);
                const f32x4 ga = *(const GAS f32x4*)(gpre + e0), gb = *(const GAS f32x4*)(gpre + e0 + 4);
                *(GAS u32x4*)(H + (size_t)m * DM + e0) = pack8(x1[2 * j] * rx * ga, x1[2 * j + 1] * rx * gb); }
        }
    }
}

template <int W>
__device__ __forceinline__ void pool_unit(const bf16* P, bf16* O, int R0, int c0) {
    const int tseq0 = R0 & (SEQ - 1);
    f32x4 Sa = (f32x4){0.f, 0.f, 0.f, 0.f}, Sb = Sa; u32x4 ring[W];
#pragma unroll
    for (int j = 0; j < W; ++j) {
        u32x4 v = (u32x4){0u, 0u, 0u, 0u};
        if (tseq0 - W + j >= 0) v = *(const GAS u32x4*)(P + (size_t)(R0 - W + j) * EI + c0);
        ring[j] = v; if (j >= 1) { Sa += unpk_lo(v); Sb += unpk_hi(v); } }
    for (int t = 0; t < 64; t += W) {
#pragma unroll
        for (int j = 0; j < W; ++j) {
            const size_t off = (size_t)(R0 + t + j) * EI + c0;
            const u32x4 cur = *(const GAS u32x4*)(P + off);
            const f32x4 ca = unpk_lo(cur), cb = unpk_hi(cur);
            Sa += ca; Sb += cb;
            const int pos = tseq0 + t + j + 1; const float inv = 1.f / (float)(pos < W ? pos : W);
            *(GAS u32x4*)(O + off) = pack8(Sa * inv - ca, Sb * inv - cb);
            ring[j] = cur;
            const u32x4 old = ring[(j + 1) % W]; Sa -= unpk_lo(old); Sb -= unpk_hi(old);
        }
    }
}
__device__ __forceinline__ void pool_phase(const Args& a, Frame& F) {
    const bf16* P = (const bf16*)(a.ws + WS_B1); bf16* O = (bf16*)(a.ws + WS_B2);
    const int gw = F.vcu * NWAVES + F.wave, NGW = F.G * NWAVES;
    for (int wu = gw; wu < (MTOK / 64) * (EI / 512); wu += NGW) {
        const int rb = wu >> 4, cb = wu & 15, R0 = 64 * rb, c0 = 512 * cb + 8 * F.lane, g = cb >> 2;
        if (g == 0) pool_unit<2>(P, O, R0, c0); else if (g == 1) pool_unit<4>(P, O, R0, c0); else if (g == 2) pool_unit<8>(P, O, R0, c0); else pool_unit<16>(P, O, R0, c0);
    }
}

__device__ __forceinline__ void poolh_phase(const Args& a, Frame& F) {
    const bf16* H = (const bf16*)(a.ws + WS_H); bf16* PH = (bf16*)(a.ws + WS_PH);
    const int gw = F.vcu * NWAVES + F.wave, NGW = F.G * NWAVES;
    for (int wu = gw; wu < (MTOK / 32) * (DM / 512); wu += NGW) {
        const int rb = wu >> 3, cb = wu & 7, R0 = 32 * rb, c0 = 512 * cb + 8 * F.lane, tseq0 = R0 & (SEQ - 1);
        u32x4 ring[16];
#pragma unroll
        for (int j = 0; j < 16; ++j) { u32x4 v = (u32x4){0u, 0u, 0u, 0u}; if (tseq0 - 16 + j >= 0) v = *(const GAS u32x4*)(H + (size_t)(R0 - 16 + j) * DM + c0); ring[j] = v; }
        f32x4 Sa[4], Sb[4];
#pragma unroll
        for (int g = 0; g < 4; ++g) { Sa[g] = (f32x4){0.f, 0.f, 0.f, 0.f}; Sb[g] = (f32x4){0.f, 0.f, 0.f, 0.f};
#pragma unroll
            for (int i = 1; i <= (2 << g); ++i) { Sa[g] += unpk_lo(ring[16 - i]); Sb[g] += unpk_hi(ring[16 - i]); } }
        const GAS u32x4* hp = (const GAS u32x4*)(H + (size_t)R0 * DM + c0);
        GAS u32x4* pp = (GAS u32x4*)(PH + (size_t)R0 * DM + c0);
        constexpr size_t ROWV = DM / 8, GRPV = (size_t)MTOK * DM / 8;
#pragma unroll 1
        for (int t = 0; t < 32; t += 16) {
#pragma unroll
            for (int jb = 0; jb < 16; jb += 8) {
                u32x4 nx[8];
#pragma unroll
                for (int q = 0; q < 8; ++q) nx[q] = hp[(size_t)q * ROWV];
                hp += 8 * ROWV;
#pragma unroll
                for (int q = 0; q < 8; ++q) { const int j = jb + q;
                    const u32x4 cur = nx[q];
                    const f32x4 ca = unpk_lo(cur), cb4 = unpk_hi(cur);
                    int pos = tseq0 + t + j + 1; asm volatile("" : "+s"(pos));
#pragma unroll
                    for (int g = 0; g < 4; ++g) { const int W = 2 << g; u32x4 old = ring[(j - W) & 15]; asm volatile("" : "+v"(old));
                        Sa[g] += ca - unpk_lo(old); Sb[g] += cb4 - unpk_hi(old);
                        const float inv = 1.f / (float)(pos < W ? pos : W);
                        pp[(size_t)g * GRPV] = pack8(Sa[g] * inv - ca, Sb[g] * inv - cb4); }
                    ring[j] = cur; pp += ROWV; }
                asm volatile("" ::: "memory");
            }
        }
    }
}

__global__ void __launch_bounds__(NWAVES * 64, 2) skel_fwd(Args args) {
    extern __shared__ __attribute__((aligned(16))) unsigned char lds[];
    Frame F;
    F.lds = (LAS unsigned char*)lds;
    F.MISC = (volatile LAS unsigned*)(F.lds + MISC_OFF);
    F.tid = threadIdx.x; F.lane = F.tid & 63; F.wave = __builtin_amdgcn_readfirstlane(F.tid >> 6);
    F.G = gridDim.x; { const int bx = blockIdx.x; F.vcu = (F.G % 8 == 0) ? (bx % 8) * (F.G / 8) + bx / 8 : bx; }
    unsigned char* ws = args.ws;
    F.ctl = (gu32*)(ws + WS_CTL);
    for (int u = F.tid; u < (LDS_BYTES - LDSCTL_OFF) / 4; u += NWAVES * 64) ((LAS unsigned*)(F.lds + LDSCTL_OFF))[u] = 0u;
    __syncthreads();
    XcdBarrier bar = xcd_barrier_post((unsigned*)(F.ctl + CW_BAR), F.MISC + 8);
    const int lo = args.ph_lo, hi = args.ph_hi;
#ifndef PH_MASK
#define PH_MASK 0x3ff
#endif
#define IN(k) ((((PH_MASK) >> (k)) & 1) && lo <= (k) && (k) < hi)
#define BOTH(k) (IN(k) && IN((k) + 1))
    bf16* const W1UZ = (bf16*)(ws + WS_W1UZ); bf16* const W1V = (bf16*)(ws + WS_W1V); bf16* const W2 = (bf16*)(ws + WS_W2); bf16* const W3 = (bf16*)(ws + WS_W3);
    bf16* const W4 = (bf16*)(ws + WS_W4); bf16* const W5 = (bf16*)(ws + WS_W5); bf16* const Hb = (bf16*)(ws + WS_H); bf16* const B0 = (bf16*)(ws + WS_B0);
    bf16* const B1 = (bf16*)(ws + WS_B1); bf16* const B2 = (bf16*)(ws + WS_B2); bf16* const Mb = (bf16*)(ws + WS_M); float* const ST = (float*)(ws + WS_ST);

    unsigned long long pc_t0 = 0, pc_r0 = 0, pc_mhz = 0;
#define PCLK_BEGIN(k) do { if (PROBE_CLK == (k) + 1 || PROBE_DUR == (k) + 1) { pc_t0 = __builtin_amdgcn_s_memtime(); pc_r0 = __builtin_amdgcn_s_memrealtime(); } } while (0)
#define PCLK_END(k) do { if (PROBE_CLK == (k) + 1) { const unsigned long long t1 = __builtin_amdgcn_s_memtime(), r1 = __builtin_amdgcn_s_memrealtime(); pc_mhz = (t1 - pc_t0) * 100ull / (r1 - pc_r0 + 1ull); } \
        if (PROBE_DUR == (k) + 1) { pc_mhz = (__builtin_amdgcn_s_memrealtime() - pc_r0) / 100ull; } } while (0)
    PCLK_BEGIN(0);
    if (IN(0)) { p0_prologue(args, F); if ((REPEAT_MASK >> 0) & 1) { __syncthreads(); p0_prologue(args, F); } if (BOTH(0)) xcd_barrier(bar); }

    PCLK_END(0);
    PCLK_BEGIN(1);
    if (IN(1)) {
#pragma unroll
        for (int rep = 0; rep < 1 + ((REPEAT_MASK >> 1) & 1); ++rep) { if (rep) __syncthreads();
        if (DELAY_P1_US > 0 && rep == 0) { const unsigned long long r0 = __builtin_amdgcn_s_memrealtime(), ticks = (unsigned long long)(blockIdx.x >> 3) * (DELAY_P1_US * 100ull) / 32ull; while (__builtin_amdgcn_s_memrealtime() - r0 < ticks) __builtin_amdgcn_s_sleep(8); __syncthreads(); }
        if (STAGGER) { conv_rounds(args, F, CSET_B, CNT_B, 0, conv_npre(F, CNT_B)); asm volatile("s_waitcnt vmcnt(0)" ::: "memory"); __syncthreads(); }
        { pg8::Gemm g{Hb, W1UZ, DM, DM, DM, 0, 0, 0, 0}; pg8::StaticOrder S; S.init(MTOK, 2 * EI, F.G, (int)blockIdx.x);
          pg8::EpiUZ E{B0, EI};
          pg8::gemm_phase<pg8::EpiUZ, pg8::StaticOrder, GALIGN, GSP2, (PROBE_EPI != 0)>(F.lds + RING_OFF, g, S, E); }
        __syncthreads();
        { pg8::Gemm g{W1V, Hb, DM, DM, DM, 0, 0, 0, 0}; pg8::StaticOrder S; S.init(EI, MTOK, F.G, (int)blockIdx.x);
          pg8::EpiGvT E{B1, MTOK, ST, MTOK};
          pg8::gemm_phase<pg8::EpiGvT, pg8::StaticOrder, GALIGN, GSP2>(F.lds + RING_OFF, g, S, E); }
        if (STAGGER) conv_rounds(args, F, CSET_B, CNT_B, conv_npre(F, CNT_B), conv_nrounds(F, CNT_B));
        }
        if (BOTH(1)) xcd_barrier(bar);
    }

    PCLK_END(1);
    PCLK_BEGIN(2);
    if (IN(2)) { sgu_phase(args, F); if ((REPEAT_MASK >> 2) & 1) { __syncthreads(); sgu_phase(args, F); } if (BOTH(2)) xcd_barrier(bar); }

    PCLK_END(2);
    PCLK_BEGIN(3);
    if (IN(3)) {
#pragma unroll
        for (int rep = 0; rep < 1 + ((REPEAT_MASK >> 3) & 1); ++rep) { if (rep) __syncthreads();
        pg8::Gemm g{B2, W2, EI, EI, EI, 0, 0, 0, 0}; pg8::StaticOrder S; S.init(MTOK, DM, F.G, (int)blockIdx.x);
        pg8::EpiPlain E{Mb, DM};
        pg8::gemm_phase<pg8::EpiPlain, pg8::StaticOrder, GALIGN, GSP2>(F.lds + RING_OFF, g, S, E);
        }
        if (BOTH(3)) xcd_barrier(bar);
    }

    PCLK_END(3);
    PCLK_BEGIN(4);
    if (IN(4)) { norm_phase<false>(Mb, args.in[IN_X], args.out, args.in[IN_POST], args.in[IN_PRE] + DM, Hb, X1BF16 ? (bf16*)(ws + WS_X1B) : nullptr, F); if ((REPEAT_MASK >> 4) & 1) norm_phase<false>(Mb, args.in[IN_X], args.out, args.in[IN_POST], args.in[IN_PRE] + DM, Hb, X1BF16 ? (bf16*)(ws + WS_X1B) : nullptr, F); if (BOTH(4)) xcd_barrier(bar); }

#if WCOMB
    PCLK_END(4);
    PCLK_BEGIN(5);
    if (IN(5)) {
#pragma unroll
        for (int rep = 0; rep < 1 + ((REPEAT_MASK >> 5) & 1); ++rep) { if (rep) __syncthreads();
#ifndef NO_POOLH
        poolh_phase(args, F);
#endif
        __syncthreads();
        { pg8::Gemm g{Hb, W3, DM, DM, DM, 0, 0, 0, 0}; pg8::StaticOrder S; S.init(MTOK, EI, F.G, (int)blockIdx.x);
          pg8::EpiPZ E{nullptr, B0, EI, 0};
          pg8::gemm_phase<pg8::EpiPZ, pg8::StaticOrder, GALIGN, GSP2>(F.lds + RING_OFF, g, S, E); }
        __syncthreads();
        { pg8::Gemm g{W4, (const bf16*)(ws + WS_W3P), GWID, EI, GWID, 0, 0, GWID / 256, (size_t)GWID * 2}; pg8::StaticOrder S; S.init(EI, DM, F.G, (int)blockIdx.x);
          pg8::EpiPlain E{(bf16*)(ws + WS_WC), DM};
          pg8::gemm_phase<pg8::EpiPlain, pg8::StaticOrder, GALIGN, GSP2>(F.lds + RING_OFF, g, S, E); }
        }
        if (BOTH(5)) xcd_barrier(bar);
    }
    PCLK_END(5);
    PCLK_BEGIN(6);
    PCLK_END(6);
    PCLK_BEGIN(7);
    if (IN(7)) {
#pragma unroll
        for (int rep = 0; rep < 1 + ((REPEAT_MASK >> 7) & 1); ++rep) { if (rep) __syncthreads();
        pg8::Gemm g{(const bf16*)(ws + WS_PH), (const bf16*)(ws + WS_WC), DM, DM, DM, GWID / 256, (size_t)MTOK * DM * 2, 0, 0}; pg8::StaticOrder S; S.init(MTOK, EI, F.G, (int)blockIdx.x);
        pg8::EpiMix E{B0, (bf16*)(ws + WS_Y1), EI, args.in[IN_BBGRP], args.in[IN_BSCALE]};
        pg8::gemm_phase<pg8::EpiMix, pg8::StaticOrder, GALIGN, GSP2>(F.lds + RING_OFF, g, S, E);
        }
        if (BOTH(7)) xcd_barrier(bar);
    }
#else
    PCLK_END(4);
    PCLK_BEGIN(5);
    if (IN(5)) {
#pragma unroll
        for (int rep = 0; rep < 1 + ((REPEAT_MASK >> 5) & 1); ++rep) { if (rep) __syncthreads();
        if (STAGGER) { conv_rounds(args, F, CSET_C, CNT_C, 0, conv_npre(F, CNT_C)); asm volatile("s_waitcnt vmcnt(0)" ::: "memory"); __syncthreads(); }
        pg8::Gemm g{Hb, W3, DM, DM, DM, 0, 0, 0, 0}; pg8::StaticOrder S; S.init(MTOK, 2 * EI, F.G, (int)blockIdx.x);
        pg8::EpiPZ E{B1, B0, EI, EI / 256};
        pg8::gemm_phase<pg8::EpiPZ, pg8::StaticOrder, GALIGN, GSP2>(F.lds + RING_OFF, g, S, E);
        if (STAGGER) conv_rounds(args, F, CSET_C, CNT_C, conv_npre(F, CNT_C), conv_nrounds(F, CNT_C));
        }
        if (BOTH(5)) xcd_barrier(bar);
    }

    PCLK_END(5);
    PCLK_BEGIN(6);
    if (IN(6)) { pool_phase(args, F); if ((REPEAT_MASK >> 6) & 1) pool_phase(args, F); if (BOTH(6)) xcd_barrier(bar); }

    PCLK_END(6);
    PCLK_BEGIN(7);
    if (IN(7)) {
#pragma unroll
        for (int rep = 0; rep < 1 + ((REPEAT_MASK >> 7) & 1); ++rep) { if (rep) __syncthreads();
        pg8::Gemm g{B2, W4, EI, GWID, GWID, GWID / 256, (size_t)GWID * 2, 0, 0}; pg8::StaticOrder S; S.init(MTOK, EI, F.G, (int)blockIdx.x);
        pg8::EpiMix E{B0, B1, EI, args.in[IN_BBGRP], args.in[IN_BSCALE]};
        pg8::gemm_phase<pg8::EpiMix, pg8::StaticOrder, GALIGN, GSP2>(F.lds + RING_OFF, g, S, E);
        }
        if (BOTH(7)) xcd_barrier(bar);
    }

#endif

    PCLK_END(7);
    PCLK_BEGIN(8);
    if (IN(8)) {
#pragma unroll
        for (int rep = 0; rep < 1 + ((REPEAT_MASK >> 8) & 1); ++rep) { if (rep) __syncthreads();
        pg8::Gemm g{WCOMB ? (const bf16*)(ws + WS_Y1) : (const bf16*)B1, W5, EI, EI, EI, 0, 0, 0, 0}; pg8::StaticOrder S; S.init(MTOK, DM, F.G, (int)blockIdx.x);
        pg8::EpiPlain E{Mb, DM};
        pg8::gemm_phase<pg8::EpiPlain, pg8::StaticOrder, GALIGN, GSP2>(F.lds + RING_OFF, g, S, E);
        }
        if (BOTH(8)) xcd_barrier(bar);
    }

    PCLK_END(8);
    PCLK_BEGIN(9);
    if (IN(9)) {
        norm_phase<true>(Mb, args.out, args.out, args.in[IN_POST] + DM, nullptr, nullptr, X1BF16 ? (bf16*)(ws + WS_X1B) : nullptr, F);
        if (__hip_atomic_load(F.ctl + CW_BAR + XB_TMO, RLX_AGENT) != 0u) {
            const int gw = F.vcu * NWAVES + F.wave, NGW = F.G * NWAVES; const float q = __builtin_nanf("");
            for (int m = gw; m < MTOK; m += NGW) { GAS f32x4* o = (GAS f32x4*)(args.out + (size_t)m * DM) + F.lane;
#pragma unroll
                for (int j = 0; j < 16; ++j) o[64 * j] = (f32x4){q, q, q, q}; } }
    }
    PCLK_END(9);
    if (PROBE_EPI != 0 && blockIdx.x == 0 && F.tid == 0) { const LAS unsigned long long* st = (const LAS unsigned long long*)(F.lds + RING_OFF + pg8::STAGE_BYTES + 1024);
        const unsigned long long v = PROBE_EPI == 1 ? (st[1] - st[0]) / 10ull : PROBE_EPI == 2 ? (st[2] - st[1]) / 10ull : PROBE_EPI == 3 ? (st[3] - st[2]) / 64ull : (st[4] - st[1]) / 100ull;
        const unsigned long long r0 = __builtin_amdgcn_s_memrealtime(), ticks = (v > 6000ull ? 6000ull : v) * 100ull; while (__builtin_amdgcn_s_memrealtime() - r0 < ticks) __builtin_amdgcn_s_sleep(32); }
    if ((PROBE_CLK != 0 || PROBE_DUR != 0) && blockIdx.x == 0 && F.tid == 0) { const unsigned long long r0 = __builtin_amdgcn_s_memrealtime(); const unsigned long long ticks = (pc_mhz > 5000ull ? 5000ull : pc_mhz) * 100ull;
        while (__builtin_amdgcn_s_memrealtime() - r0 < ticks) __builtin_amdgcn_s_sleep(32); }
#undef IN
#undef BOTH
}

#if NAIVE_MASK != 0
#if WCOMB && (NAIVE_MASK & 0xE0)
#error "the reference implementations of phases 5-7 follow the literal order: build them with WCOMB 0"
#endif
__device__ __forceinline__ bf16 nv_f2bf(float f) { unsigned u = __float_as_uint(f); u += 0x7fffu + ((u >> 16) & 1u); return (bf16)(u >> 16); }
__device__ __forceinline__ float nv_bf2f(bf16 b) { return __uint_as_float(((unsigned)b) << 16); }
__device__ __forceinline__ float nv_gelu(float v) { return 0.5f * v * (1.0f + erff(v * 0.70710678118654752f)); }
__device__ __forceinline__ float nv_silu(float v) { return v / (1.0f + expf(-v)); }
__global__ void nv_transpose(const float* W, int ldw, int K, int Nd, bf16* WT, int mode) {
    const size_t total = (size_t)Nd * K;
    for (size_t i = (size_t)blockIdx.x * blockDim.x + threadIdx.x; i < total; i += (size_t)gridDim.x * blockDim.x) {
        const int r = (int)(i / K), k = (int)(i % K); int c = r;
        if (mode == 1) { const int t = r >> 8, j = r & 255; c = j < 128 ? 128 * t + j : 2 * EI + 128 * t + (j - 128); }
        if (mode == 2) c = EI + r;
        WT[i] = nv_f2bf(W[(size_t)k * ldw + c]); }
}
__global__ void nv_rms_h(const float* x, const float* g, bf16* H) {
    const int m = blockIdx.x, lane = threadIdx.x; float s = 0.f;
    for (int c = lane; c < DM; c += 64) { const float v = x[(size_t)m * DM + c]; s += v * v; }
    for (int o = 1; o < 64; o <<= 1) s += __shfl_xor(s, o);
    const float rstd = 1.f / sqrtf(s / DM + EPS);
    for (int c = lane; c < DM; c += 64) H[(size_t)m * DM + c] = nv_f2bf(x[(size_t)m * DM + c] * rstd * g[c]);
}
struct NvUZ { bf16* U; bf16* Zt; __device__ void operator()(int r, int c, float v) const { const int t = c >> 8, j = c & 255;
    if (j < 128) U[(size_t)r * EI + 128 * t + j] = nv_f2bf(nv_gelu(v)); else Zt[(size_t)r * EI + 128 * t + (j - 128)] = nv_f2bf(nv_silu(v)); } };
struct NvGvT { bf16* O; __device__ void operator()(int r, int c, float v) const { O[(size_t)c * MTOK + r] = nv_f2bf(nv_gelu(v)); } };
struct NvPlain { bf16* O; int ldc; int pad; __device__ void operator()(int r, int c, float v) const { O[(size_t)r * ldc + c] = nv_f2bf(v); } };
struct NvPZ { bf16* P; bf16* SZ; __device__ void operator()(int r, int c, float v) const { if (c < EI) P[(size_t)r * EI + c] = nv_f2bf(v); else SZ[(size_t)r * EI + c - EI] = nv_f2bf(nv_silu(v)); } };
struct NvMix { const bf16* SZ; bf16* Y; const float* bgrp; const float* scale; int g; int pad; __device__ void operator()(int r, int c, float v) const { const int ch = g * GWID + c;
    Y[(size_t)r * EI + ch] = nv_f2bf((v + bgrp[ch]) * scale[ch] * nv_bf2f(SZ[(size_t)r * EI + ch])); } };
template <class Epi> __global__ void __launch_bounds__(256) nv_gemm(const bf16* A, int lda, const bf16* Bt, int ldb, int K, Epi epi) {
    __shared__ float As[16][65], Bs[16][65];
    const int tid = threadIdx.x, tx = tid & 15, ty = tid >> 4, row0 = blockIdx.y * 64, col0 = blockIdx.x * 64;
    float acc[4][4];
#pragma unroll
    for (int i = 0; i < 4; ++i)
#pragma unroll
        for (int j = 0; j < 4; ++j) acc[i][j] = 0.f;
    const int lr = tid >> 2, lk = (tid & 3) * 4;
    for (int k0 = 0; k0 < K; k0 += 16) {
#pragma unroll
        for (int i = 0; i < 4; ++i) { As[lk + i][lr] = nv_bf2f(A[(size_t)(row0 + lr) * lda + k0 + lk + i]); Bs[lk + i][lr] = nv_bf2f(Bt[(size_t)(col0 + lr) * ldb + k0 + lk + i]); }
        __syncthreads();
#pragma unroll
        for (int k = 0; k < 16; ++k) { float av[4], bv[4];
#pragma unroll
            for (int i = 0; i < 4; ++i) { av[i] = As[k][ty * 4 + i]; bv[i] = Bs[k][tx * 4 + i]; }
#pragma unroll
            for (int i = 0; i < 4; ++i)
#pragma unroll
                for (int j = 0; j < 4; ++j) acc[i][j] += av[i] * bv[j]; }
        __syncthreads();
    }
#pragma unroll
    for (int i = 0; i < 4; ++i)
#pragma unroll
        for (int j = 0; j < 4; ++j) epi(row0 + ty * 4 + i, col0 + tx * 4 + j, acc[i][j]);
}
__global__ void nv_mul(bf16* U, const bf16* Zt, size_t n) { for (size_t i = (size_t)blockIdx.x * blockDim.x + threadIdx.x; i < n; i += (size_t)gridDim.x * blockDim.x) U[i] = nv_f2bf(nv_bf2f(U[i]) * nv_bf2f(Zt[i])); }
__global__ void nv_stats(const bf16* GVT, float* ST) {
    const int tok = blockIdx.x * blockDim.x + threadIdx.x; if (tok >= MTOK) return; float s = 0.f, ss = 0.f;
    for (int ch = 0; ch < EI; ++ch) { const float v = nv_bf2f(GVT[(size_t)ch * MTOK + tok]); s += v; ss += v * v; }
    ST[(size_t)tok * 2] = s; ST[(size_t)tok * 2 + 1] = ss;
    for (int p = 1; p < NST; ++p) { ST[((size_t)p * MTOK + tok) * 2] = 0.f; ST[((size_t)p * MTOK + tok) * 2 + 1] = 0.f; }
}
__global__ void nv_murs(const float* ST, float* MR) {
    const int tok = blockIdx.x * blockDim.x + threadIdx.x; if (tok >= MTOK) return; float s = 0.f, ss = 0.f;
    for (int p = 0; p < NST; ++p) { s += ST[((size_t)p * MTOK + tok) * 2]; ss += ST[((size_t)p * MTOK + tok) * 2 + 1]; }
    const float mean = s / EI; float var = ss / EI - mean * mean; var = var > 0.f ? var : 0.f; MR[tok * 2] = mean; MR[tok * 2 + 1] = 1.f / sqrtf(var + EPS);
}
__global__ void nv_sgu(const bf16* GVT, const float* MR, const bf16* UZ, const float* lng, const float* lnb, const float* wsp, const float* bsv, bf16* Y) {
    const size_t total = (size_t)MTOK * EI;
    for (size_t i = (size_t)blockIdx.x * blockDim.x + threadIdx.x; i < total; i += (size_t)gridDim.x * blockDim.x) {
        const int ch = (int)(i / MTOK), tok = (int)(i % MTOK), h = ch / HDIM, t = tok & (CHUNK - 1), R0 = tok - t;
        float sv = 0.f;
        for (int s = 0; s <= t; ++s) { const float vn = (nv_bf2f(GVT[(size_t)ch * MTOK + R0 + s]) - MR[(R0 + s) * 2]) * MR[(R0 + s) * 2 + 1] * lng[ch] + lnb[ch];
            sv += wsp[((size_t)h * CHUNK + t) * CHUNK + s] * vn; }
        sv += bsv[h * CHUNK + t];
        Y[(size_t)tok * EI + ch] = nv_f2bf(nv_bf2f(UZ[(size_t)tok * EI + ch]) * sv); }
}
__global__ void nv_pool(const bf16* P, bf16* O) {
    const size_t total = (size_t)MTOK * EI;
    for (size_t i = (size_t)blockIdx.x * blockDim.x + threadIdx.x; i < total; i += (size_t)gridDim.x * blockDim.x) {
        const int tok = (int)(i / EI), ch = (int)(i % EI), g = ch / GWID, W = 2 << g, tseq = tok & (SEQ - 1), cnt = (tseq + 1 < W) ? tseq + 1 : W;
        float s = 0.f; for (int j = 0; j < cnt; ++j) s += nv_bf2f(P[(size_t)(tok - j) * EI + ch]);
        O[i] = nv_f2bf(s / (float)cnt - nv_bf2f(P[i])); }
}
static void launch_naive_phase(int k, const Args& a, hipStream_t stream) {
    unsigned char* ws = a.ws;
    bf16* W1UZ = (bf16*)(ws + WS_W1UZ); bf16* W1V = (bf16*)(ws + WS_W1V); bf16* W2 = (bf16*)(ws + WS_W2); bf16* W3 = (bf16*)(ws + WS_W3); bf16* W4 = (bf16*)(ws + WS_W4); bf16* W5 = (bf16*)(ws + WS_W5);
    bf16* Hb = (bf16*)(ws + WS_H); bf16* B0 = (bf16*)(ws + WS_B0); bf16* B1 = (bf16*)(ws + WS_B1); bf16* B2 = (bf16*)(ws + WS_B2); bf16* Mb = (bf16*)(ws + WS_M); float* ST = (float*)(ws + WS_ST); float* MR = (float*)(ws + WS_DBG);
    const dim3 blk(256);
    switch (k) {
    case 0:
        hipLaunchKernelGGL(nv_transpose, dim3(8192), blk, 0, stream, a.in[IN_AWIN], 3 * EI, DM, 2 * EI, W1UZ, 1);
        hipLaunchKernelGGL(nv_transpose, dim3(8192), blk, 0, stream, a.in[IN_AWIN], 3 * EI, DM, EI, W1V, 2);
        hipLaunchKernelGGL(nv_transpose, dim3(8192), blk, 0, stream, a.in[IN_AWOUT], DM, EI, DM, W2, 0);
        hipLaunchKernelGGL(nv_transpose, dim3(8192), blk, 0, stream, a.in[IN_BWIN], 2 * EI, DM, 2 * EI, W3, 0);
        for (int g = 0; g < NGRP; ++g) hipLaunchKernelGGL(nv_transpose, dim3(4096), blk, 0, stream, a.in[IN_BWGRP] + (size_t)g * GWID * GWID, GWID, GWID, GWID, W4 + (size_t)g * GWID * GWID, 0);
        hipLaunchKernelGGL(nv_transpose, dim3(8192), blk, 0, stream, a.in[IN_BWOUT], DM, EI, DM, W5, 0);
        hipLaunchKernelGGL(nv_rms_h, dim3(MTOK), dim3(64), 0, stream, a.in[IN_X], a.in[IN_PRE], Hb);
        break;
    case 1:
        hipLaunchKernelGGL(nv_gemm<NvUZ>, dim3(2 * EI / 64, MTOK / 64), blk, 0, stream, (const bf16*)Hb, DM, (const bf16*)W1UZ, DM, DM, NvUZ{B0, B2});
        hipLaunchKernelGGL(nv_mul, dim3(8192), blk, 0, stream, B0, (const bf16*)B2, (size_t)MTOK * EI);
        hipLaunchKernelGGL(nv_gemm<NvGvT>, dim3(EI / 64, MTOK / 64), blk, 0, stream, (const bf16*)Hb, DM, (const bf16*)W1V, DM, DM, NvGvT{B1});
        hipLaunchKernelGGL(nv_stats, dim3(MTOK / 256), blk, 0, stream, (const bf16*)B1, ST);
        break;
    case 2:
        hipLaunchKernelGGL(nv_murs, dim3(MTOK / 256), blk, 0, stream, (const float*)ST, MR);
        hipLaunchKernelGGL(nv_sgu, dim3(16384), blk, 0, stream, (const bf16*)B1, (const float*)MR, (const bf16*)B0, a.in[IN_ALNG], a.in[IN_ALNB], a.in[IN_AWS], a.in[IN_ABS], B2);
        break;
    case 3: hipLaunchKernelGGL(nv_gemm<NvPlain>, dim3(DM / 64, MTOK / 64), blk, 0, stream, (const bf16*)B2, EI, (const bf16*)W2, EI, EI, NvPlain{Mb, DM, 0}); break;
    case 5: hipLaunchKernelGGL(nv_gemm<NvPZ>, dim3(2 * EI / 64, MTOK / 64), blk, 0, stream, (const bf16*)Hb, DM, (const bf16*)W3, DM, DM, NvPZ{B1, B0}); break;
    case 6: hipLaunchKernelGGL(nv_pool, dim3(16384), blk, 0, stream, (const bf16*)B1, B2); break;
    case 7:
        for (int g = 0; g < NGRP; ++g) hipLaunchKernelGGL(nv_gemm<NvMix>, dim3(GWID / 64, MTOK / 64), blk, 0, stream, (const bf16*)B2 + (size_t)g * GWID, EI, (const bf16*)W4 + (size_t)g * GWID * GWID, GWID, GWID,
                                                          NvMix{(const bf16*)B0, B1, a.in[IN_BBGRP], a.in[IN_BSCALE], g, 0});
        break;
    case 8: hipLaunchKernelGGL(nv_gemm<NvPlain>, dim3(DM / 64, MTOK / 64), blk, 0, stream, (const bf16*)B1, EI, (const bf16*)W5, EI, EI, NvPlain{Mb, DM, 0}); break;
    default: break;
    }
}
#endif

extern "C" void kernel_launch(void* const* d_in, const int* in_sizes, int n_in, void* d_out, int out_size, void* d_ws, size_t ws_size, hipStream_t stream) {
    static int grid = 0;
    if (grid == 0) {
        if (n_in != N_IN || in_sizes[0] != MTOK * DM || out_size != MTOK * DM || ws_size < WS_END) {
            fprintf(stderr, "kernel_launch: built for %d inputs, x and out of %d floats, >= %zu bytes of workspace; got n_in %d, in0 %d, out %d, ws %zu; nothing launched\n", (int)N_IN, MTOK * DM, (size_t)WS_END, n_in, n_in > 0 ? in_sizes[0] : -1, out_size, ws_size); grid = -1; return; }
        int dev = 0, cus = 0, per_cu = 0;
        if (hipGetDevice(&dev) != hipSuccess || hipDeviceGetAttribute(&cus, hipDeviceAttributeMultiprocessorCount, dev) != hipSuccess) { fprintf(stderr, "kernel_launch: hipGetDevice / hipDeviceGetAttribute failed; nothing launched\n"); grid = -1; return; }
        if (hipFuncSetAttribute((const void*)skel_fwd, hipFuncAttributeMaxDynamicSharedMemorySize, LDS_BYTES) != hipSuccess) { fprintf(stderr, "kernel_launch: hipFuncSetAttribute failed (%d bytes of dynamic LDS); nothing launched\n", LDS_BYTES); grid = -1; return; }
        if (hipOccupancyMaxActiveBlocksPerMultiprocessor(&per_cu, (const void*)skel_fwd, NWAVES * 64, LDS_BYTES) != hipSuccess || per_cu < 1)
            fprintf(stderr, "kernel_launch: note: the occupancy query reports %d workgroups per CU; launching one per CU\n", per_cu);
        (void)hipGetLastError();
        grid = cus;
    }
    if (grid < 0) return;
    if (hipMemsetAsync((char*)d_ws + WS_CTL, 0, CTL_ZERO_BYTES, stream) != hipSuccess) { fprintf(stderr, "kernel_launch: hipMemsetAsync of the control words failed; nothing launched\n"); return; }
    Args a{};
    for (int i = 0; i < N_IN; ++i) a.in[i] = (const float*)d_in[i];
    a.out = (float*)d_out; a.ws = (unsigned char*)d_ws;
#if NAIVE_MASK == 0
    a.ph_lo = 0; a.ph_hi = NPH;
    hipLaunchKernelGGL(skel_fwd, dim3(grid), dim3(NWAVES * 64), LDS_BYTES, stream, a);
    { const hipError_t le = hipPeekAtLastError(); if (le != hipSuccess) fprintf(stderr, "kernel_launch: launch failed: %s (grid %d x %d threads, %d B LDS)\n", hipGetErrorName(le), grid, NWAVES * 64, LDS_BYTES); }
#else
    for (int k = 0; k < NPH; ++k) {
        if ((NAIVE_MASK >> k) & 1 && k != 4 && k != 9) { launch_naive_phase(k, a, stream); continue; }
        a.ph_lo = k; a.ph_hi = k + 1;
        hipLaunchKernelGGL(skel_fwd, dim3(grid), dim3(NWAVES * 64), LDS_BYTES, stream, a);
        const hipError_t le = hipPeekAtLastError(); if (le != hipSuccess) { fprintf(stderr, "kernel_launch: launch of phase %d failed: %s\n", k, hipGetErrorName(le)); break; }
    }
#endif
}
```

```cpp
#include <hip/hip_runtime.h>
#include <cstdio>
#include <cstdint>

#ifndef NAIVE_MASK
#define NAIVE_MASK 0
#endif
#ifndef REPEAT_MASK
#define REPEAT_MASK 0
#endif
#ifndef STAGGER
#define STAGGER 0
#endif
#ifndef DELAY_P1_US
#define DELAY_P1_US 0
#endif
#ifndef GSP2
#define GSP2 true
#endif
#ifndef GSETPRIO
#define GSETPRIO 1
#endif
#ifndef GALIGN
#define GALIGN true
#endif
#ifndef WCOMB
#define WCOMB 1
#endif
#ifndef PROBE_EPI
#define PROBE_EPI 0
#endif
#ifndef PROBE_DUR
#define PROBE_DUR 0
#endif
#ifndef WDROP
#define WDROP 2
#endif
#ifndef X1BF16
#define X1BF16 1
#endif
#ifndef PROBE_CLK
#define PROBE_CLK 0
#endif

namespace pg8 {
#define PG8_LAS __attribute__((address_space(3)))
typedef unsigned short bf16_t;
typedef short bf16x8 __attribute__((ext_vector_type(8)));
typedef float f32x4 __attribute__((ext_vector_type(4)));
typedef unsigned u32x4 __attribute__((ext_vector_type(4)));
constexpr int BM = 256, BK = 64, HALF = 128, HTB = HALF * BK * 2  , STAGE_BYTES = 8 * HTB, NXCD = 8, WGM = 8;

__host__ __device__ __forceinline__ int lds_byte(int r, int c) { const int st = (r >> 4) * 2 + (c >> 5), rr = r & 15, cc = c & 31, ob = rr * 64 + cc * 2; return st * 1024 + (ob ^ (((ob >> 9) & 1) << 5)); }
__host__ __device__ __forceinline__ void stage_rc(int b, int& R, int& C) { const int st = b / 1024, sb = b % 1024, swz = sb ^ (((sb >> 9) & 1) << 5); R = (st >> 1) * 16 + swz / 64; C = (st & 1) * 32 + (swz % 64) / 2; }
__host__ __device__ __forceinline__ int perm32(int rho) { const int n = rho >> 4, i = rho & 15; return 8 * (i >> 2) + 4 * n + (i & 3); }

struct Unit { int pm, pn; };
struct Gemm { const bf16_t* A; const bf16_t* Bt; int lda, ldb, K; int agrp_tiles; size_t agrp_bytes; int bgrp_tiles; size_t bgrp_bytes;
    __device__ __forceinline__ size_t acol(int pn) const { return agrp_tiles ? (size_t)(pn / agrp_tiles) * agrp_bytes : (size_t)0; }
    __device__ __forceinline__ size_t bcol(int pm) const { return bgrp_tiles ? (size_t)(pm / bgrp_tiles) * bgrp_bytes : (size_t)0; } };

struct StaticOrder {
    int nM, nN, nwg, G, c;
    __host__ __device__ void init(int M, int N, int G_, int c_) { nM = M / BM; nN = N / BM; nwg = nM * nN; G = G_; c = c_; }
    __host__ __device__ bool next(int i, Unit& u) const {
        const long L = (long)i * G + c; if (L >= nwg) return false;
        int wgid = (int)L; { const int q = nwg / NXCD, r = nwg % NXCD, xcd = wgid % NXCD, off = wgid / NXCD; wgid = (xcd < r ? xcd * (q + 1) : r * (q + 1) + (xcd - r) * q) + off; }
        const int nig = WGM * nN, gid = wgid / nig, fm = gid * WGM, gsz = (nM - fm) < WGM ? (nM - fm) : WGM;
        u.pm = fm + ((wgid % nig) % gsz); u.pn = (wgid % nig) / gsz; return true;
    }
    __device__ __forceinline__ void a_ready(const Unit&) const {}
    __device__ __forceinline__ void done(const Unit&) const {}
};

__device__ __forceinline__ unsigned cvt_pk_bf16(float lo, float hi) { unsigned r; asm volatile("v_cvt_pk_bf16_f32 %0, %1, %2" : "=v"(r) : "v"(lo), "v"(hi)); return r; }
typedef float f32x2 __attribute__((ext_vector_type(2)));
__device__ __forceinline__ f32x2 gelu_pk(f32x2 v) {
    const f32x2 av = __builtin_elementwise_abs(v), d = av * 0.2316418882f + 1.0f;
    f32x2 t; t.x = __builtin_amdgcn_rcpf(d.x); t.y = __builtin_amdgcn_rcpf(d.y);
    f32x2 q = t * 0.5307027145f + (-0.7265760135f); q = q * t + 0.7107068705f; q = q * t + (-0.142248368f); q = q * t + 0.127414796f; q = q * t;
    const f32x2 s = (v * v) * (-0.72134752044f);
    f32x2 e; e.x = __builtin_amdgcn_exp2f(s.x); e.y = __builtin_amdgcn_exp2f(s.y);
    const f32x2 m = v * (q * e), r = v - m;
    f32x2 o; o.x = v.x < 0.f ? m.x : r.x; o.y = v.y < 0.f ? m.y : r.y; return o;
}

__device__ __forceinline__ float silu1(float z) { return z * __builtin_amdgcn_rcpf(1.0f + __builtin_amdgcn_exp2f(z * -1.4426950408889634f)); }
__device__ __forceinline__ f32x4 gelu4(f32x4 v) { const f32x2 a = gelu_pk((f32x2){v[0], v[1]}), b = gelu_pk((f32x2){v[2], v[3]}); return (f32x4){a.x, a.y, b.x, b.y}; }
__device__ __forceinline__ f32x4 silu4(f32x4 v) { return (f32x4){silu1(v[0]), silu1(v[1]), silu1(v[2]), silu1(v[3])}; }
__device__ __forceinline__ u32x4 pack8(f32x4 a, f32x4 b) { u32x4 w; w.x = cvt_pk_bf16(a[0], a[1]); w.y = cvt_pk_bf16(a[2], a[3]); w.z = cvt_pk_bf16(b[0], b[1]); w.w = cvt_pk_bf16(b[2], b[3]); return w; }
__device__ __forceinline__ f32x4 unpk_lo(u32x4 w) { return (f32x4){__uint_as_float(w.x << 16), __uint_as_float(w.x & 0xffff0000u), __uint_as_float(w.y << 16), __uint_as_float(w.y & 0xffff0000u)}; }
__device__ __forceinline__ f32x4 unpk_hi(u32x4 w) { return (f32x4){__uint_as_float(w.z << 16), __uint_as_float(w.z & 0xffff0000u), __uint_as_float(w.w << 16), __uint_as_float(w.w & 0xffff0000u)}; }

#ifndef EPI_NT
#define EPI_NT 0
#endif
__device__ __forceinline__ void st16(bf16_t* p, u32x4 v) { if (EPI_NT) __builtin_nontemporal_store(v, (u32x4*)p); else *(u32x4*)p = v; }
__device__ __forceinline__ float row16_sum(float v) {
    v += __builtin_bit_cast(float, __builtin_amdgcn_update_dpp(0, __builtin_bit_cast(int, v), 0x128, 0xf, 0xf, false));
    v += __builtin_bit_cast(float, __builtin_amdgcn_update_dpp(0, __builtin_bit_cast(int, v), 0x124, 0xf, 0xf, false));
    v += __builtin_bit_cast(float, __builtin_amdgcn_update_dpp(0, __builtin_bit_cast(int, v), 0x122, 0xf, 0xf, false));
    v += __builtin_bit_cast(float, __builtin_amdgcn_update_dpp(0, __builtin_bit_cast(int, v), 0x121, 0xf, 0xf, false));
    return v;
}
struct EpiPlain {
    static constexpr bool PERM = true, AFTER_DRAIN = false;
    bf16_t* O; int ldc;
    __device__ __forceinline__ void operator()(const f32x4 (&acc)[2][2][4][2], const Unit& u, int wr, int wc, int fr, int fq) const {
        const int row0 = u.pm * BM + wr * 64 + fr, col0 = u.pn * BM + wc * 32 + 8 * fq;
#pragma unroll
        for (int ai = 0; ai < 2; ++ai)
#pragma unroll
            for (int m = 0; m < 4; ++m) { bf16_t* rowp = O + (size_t)(row0 + ai * HALF + m * 16) * ldc + col0;
#pragma unroll
                for (int bj = 0; bj < 2; ++bj) st16(rowp + bj * HALF, pack8(acc[ai][bj][m][0], acc[ai][bj][m][1])); }
    }
};
struct EpiUZ {
    static constexpr bool PERM = true, AFTER_DRAIN = false;
    bf16_t* O; int ldc;
    __device__ __forceinline__ void operator()(const f32x4 (&acc)[2][2][4][2], const Unit& u, int wr, int wc, int fr, int fq) const {
        const int row0 = u.pm * BM + wr * 64 + fr, ch0 = u.pn * HALF + wc * 32 + 8 * fq;
#pragma unroll
        for (int ai = 0; ai < 2; ++ai)
#pragma unroll
            for (int m = 0; m < 4; ++m) { bf16_t* rowp = O + (size_t)(row0 + ai * HALF + m * 16) * ldc + ch0;
                const f32x4 g0 = gelu4(acc[ai][0][m][0]), g1 = gelu4(acc[ai][0][m][1]), s0 = silu4(acc[ai][1][m][0]), s1 = silu4(acc[ai][1][m][1]);
                st16(rowp, pack8(g0 * s0, g1 * s1)); }
    }
};
struct EpiGvT {
    static constexpr bool PERM = true, AFTER_DRAIN = false;
    bf16_t* O; int ldc; float* ST; int ntok;
    __device__ __forceinline__ void operator()(const f32x4 (&acc)[2][2][4][2], const Unit& u, int wr, int wc, int fr, int fq) const {
        const int ch0 = u.pm * BM + wr * 64 + fr, tok0 = u.pn * BM + wc * 32 + 8 * fq;
        f32x4 s1[2][2], s2[2][2];
#pragma unroll
        for (int bj = 0; bj < 2; ++bj)
#pragma unroll
            for (int n = 0; n < 2; ++n) { s1[bj][n] = (f32x4){0.f, 0.f, 0.f, 0.f}; s2[bj][n] = (f32x4){0.f, 0.f, 0.f, 0.f}; }
#pragma unroll
        for (int ai = 0; ai < 2; ++ai)
#pragma unroll
            for (int m = 0; m < 4; ++m) { bf16_t* rowp = O + (size_t)(ch0 + ai * HALF + m * 16) * ldc + tok0;
#pragma unroll
                for (int bj = 0; bj < 2; ++bj) { const f32x4 v0 = gelu4(acc[ai][bj][m][0]), v1 = gelu4(acc[ai][bj][m][1]);
                    s1[bj][0] += v0; s2[bj][0] += v0 * v0; s1[bj][1] += v1; s2[bj][1] += v1 * v1;
                    st16(rowp + bj * HALF, pack8(v0, v1)); } }
#pragma unroll
        for (int bj = 0; bj < 2; ++bj)
#pragma unroll
            for (int n = 0; n < 2; ++n)
#pragma unroll
                for (int e = 0; e < 4; ++e) { s1[bj][n][e] = row16_sum(s1[bj][n][e]); s2[bj][n][e] = row16_sum(s2[bj][n][e]); }
        if (fr == 0) { float* st = ST + ((size_t)(u.pm * 2 + wr) * ntok + tok0) * 2;
#pragma unroll
            for (int bj = 0; bj < 2; ++bj)
#pragma unroll
                for (int n = 0; n < 2; ++n) { float* q = st + (bj * HALF + 4 * n) * 2;
                    *(f32x4*)q = (f32x4){s1[bj][n][0], s2[bj][n][0], s1[bj][n][1], s2[bj][n][1]};
                    *(f32x4*)(q + 4) = (f32x4){s1[bj][n][2], s2[bj][n][2], s1[bj][n][3], s2[bj][n][3]}; } }
    }
};
struct EpiPZ {
    static constexpr bool PERM = true, AFTER_DRAIN = false;
    bf16_t* P; bf16_t* SZ; int ldc; int nP;
    __device__ __forceinline__ void operator()(const f32x4 (&acc)[2][2][4][2], const Unit& u, int wr, int wc, int fr, int fq) const {
        const bool isz = u.pn >= nP; bf16_t* base = isz ? SZ : P;
        const int row0 = u.pm * BM + wr * 64 + fr, col0 = (isz ? u.pn - nP : u.pn) * BM + wc * 32 + 8 * fq;
#pragma unroll
        for (int ai = 0; ai < 2; ++ai)
#pragma unroll
            for (int m = 0; m < 4; ++m) { bf16_t* rowp = base + (size_t)(row0 + ai * HALF + m * 16) * ldc + col0;
#pragma unroll
                for (int bj = 0; bj < 2; ++bj) { f32x4 v0 = acc[ai][bj][m][0], v1 = acc[ai][bj][m][1];
                    if (isz) { v0 = silu4(v0); v1 = silu4(v1); }
                    st16(rowp + bj * HALF, pack8(v0, v1)); } }
    }
};
struct EpiMix {
    static constexpr bool PERM = true, AFTER_DRAIN = false;
    const bf16_t* SZ; bf16_t* Y; int ldc; const float* bgrp; const float* scale;
    __device__ __forceinline__ void operator()(const f32x4 (&acc)[2][2][4][2], const Unit& u, int wr, int wc, int fr, int fq) const {
        const int row0 = u.pm * BM + wr * 64 + fr, ch0 = u.pn * BM + wc * 32 + 8 * fq;
        f32x4 sc[2][2], bs[2][2];
#pragma unroll
        for (int bj = 0; bj < 2; ++bj)
#pragma unroll
            for (int n = 0; n < 2; ++n) { sc[bj][n] = *(const f32x4*)(scale + ch0 + bj * HALF + 4 * n); bs[bj][n] = *(const f32x4*)(bgrp + ch0 + bj * HALF + 4 * n) * sc[bj][n]; }
#pragma unroll
        for (int ai = 0; ai < 2; ++ai) {
            u32x4 z[4][2];
#pragma unroll
            for (int m = 0; m < 4; ++m)
#pragma unroll
                for (int bj = 0; bj < 2; ++bj) z[m][bj] = *(const u32x4*)(SZ + (size_t)(row0 + ai * HALF + m * 16) * ldc + ch0 + bj * HALF);
#pragma unroll
            for (int m = 0; m < 4; ++m) { const size_t off = (size_t)(row0 + ai * HALF + m * 16) * ldc + ch0;
#pragma unroll
                for (int bj = 0; bj < 2; ++bj) {
                    const f32x4 v0 = (acc[ai][bj][m][0] * sc[bj][0] + bs[bj][0]) * unpk_lo(z[m][bj]), v1 = (acc[ai][bj][m][1] * sc[bj][1] + bs[bj][1]) * unpk_hi(z[m][bj]);
                    st16(Y + off + bj * HALF, pack8(v0, v1)); } } }
    }
};

template <class Epi, class Sched, bool ALIGN_EPI = false, bool SP2 = false, bool PROBE = false>
__device__ __forceinline__ void gemm_phase(PG8_LAS unsigned char* lds, const Gemm g, const Sched& S, const Epi& E) {
#define PG8_PSTAMP(k) do { if (PROBE && blockIdx.x == 0 && threadIdx.x == 0) ((PG8_LAS unsigned long long*)(lds + STAGE_BYTES + 1024))[k] = __builtin_amdgcn_s_memtime(); } while (0)
    const int tid = threadIdx.x, wid = __builtin_amdgcn_readfirstlane(tid >> 6), lane = tid & 63, wr = wid >> 2, wc = wid & 3, fr = lane & 15, fq = lane >> 4;
    const int K = g.K, nt = K / BK;
    unsigned voffA[2], voffB[2];
#pragma unroll
    for (int i = 0; i < 2; ++i) { int R, C; stage_rc(tid * 16 + i * 8192, R, C); const int Rb = Epi::PERM ? ((R & ~31) + perm32(R & 31)) : R;
        voffA[i] = (unsigned)(R * g.lda + C) * 2u; voffB[i] = (unsigned)(Rb * g.ldb + C) * 2u; }
    const size_t kstep = (size_t)(BK * 2);
    const size_t hstepA = (size_t)HALF * g.lda * 2, hstepB = (size_t)HALF * g.ldb * 2;
    const size_t tstepA = 2 * hstepA, tstepB = 2 * hstepB;
    const unsigned ldsw = (unsigned)wid * 1024u;
    const int aoff = lds_byte(wr * 64 + fr, fq * 8), boff = lds_byte(wc * 32 + fr, fq * 8);
#define PG8_SA(b, h) (((b) * 2 + (h)) * HTB)
#define PG8_SB(b, h) ((4 + (b) * 2 + (h)) * HTB)
#define PG8_STAGE(bufoff, gbase, voff) do { _Pragma("unroll") for (int _i = 0; _i < 2; ++_i) \
        __builtin_amdgcn_global_load_lds((const unsigned*)((const char*)(gbase) + (voff)[_i]), (PG8_LAS unsigned*)(lds + (bufoff) + ldsw + _i * 8192), 16, 0, 0); } while (0)
#define PG8_LDA(dst, b, h) do { _Pragma("unroll") for (int m = 0; m < 4; ++m) _Pragma("unroll") for (int k = 0; k < 2; ++k) dst[m][k] = *(const PG8_LAS bf16x8*)(lds + PG8_SA(b, h) + aoff + m * 2048 + k * 1024); } while (0)
#define PG8_LDB(dst, b, h) do { _Pragma("unroll") for (int n = 0; n < 2; ++n) _Pragma("unroll") for (int k = 0; k < 2; ++k) dst[n][k] = *(const PG8_LAS bf16x8*)(lds + PG8_SB(b, h) + boff + n * 2048 + k * 1024); } while (0)
#define PG8_MMA(ai, bj, At, Bt) do { if (GSETPRIO) __builtin_amdgcn_s_setprio(1); _Pragma("unroll") for (int m = 0; m < 4; ++m) _Pragma("unroll") for (int n = 0; n < 2; ++n) _Pragma("unroll") for (int k = 0; k < 2; ++k) \
        acc[ai][bj][m][n] = __builtin_amdgcn_mfma_f32_16x16x32_bf16(Bt[n][k], At[m][k], acc[ai][bj][m][n], 0, 0, 0); if (GSETPRIO) __builtin_amdgcn_s_setprio(0); } while (0)
#define PG8_WAIT_V(n) asm volatile("s_waitcnt vmcnt(" #n ")" ::: "memory")
#define PG8_WAIT_L(n) asm volatile("s_waitcnt lgkmcnt(" #n ")" ::: "memory")
#define PG8_BAR __builtin_amdgcn_s_barrier()
#define PG8_SCHED __builtin_amdgcn_sched_barrier(0)
    Unit cur, nxt; int ui = 0;
    if (!S.next(0, cur)) return;
    f32x4 acc[2][2][4][2];
#pragma unroll
    for (int a = 0; a < 2; ++a)
#pragma unroll
        for (int b = 0; b < 2; ++b)
#pragma unroll
            for (int m = 0; m < 4; ++m)
#pragma unroll
                for (int n = 0; n < 2; ++n) acc[a][b][m][n] = (f32x4){0.f, 0.f, 0.f, 0.f};
    bf16x8 At[4][2], B0[2][2], B1[2][2];
    const char* cA = (const char*)g.A + (size_t)cur.pm * tstepA + g.acol(cur.pn); const char* cB = (const char*)g.Bt + (size_t)cur.pn * tstepB + g.bcol(cur.pm);
    S.a_ready(cur);
    if constexpr (SP2) {
        PG8_STAGE(PG8_SB(0, 0), cB, voffB); PG8_STAGE(PG8_SB(0, 1), cB + hstepB, voffB); PG8_STAGE(PG8_SA(0, 0), cA, voffA); PG8_STAGE(PG8_SA(0, 1), cA + hstepA, voffA);
        if (wr == 1) PG8_BAR;
        PG8_WAIT_V(2); PG8_BAR;
        PG8_STAGE(PG8_SB(1, 0), cB + kstep, voffB); PG8_STAGE(PG8_SA(1, 0), cA + kstep, voffA); PG8_STAGE(PG8_SB(1, 1), cB + hstepB + kstep, voffB);
        PG8_WAIT_V(6); PG8_BAR;
    } else {
        PG8_STAGE(PG8_SB(0, 0), cB, voffB); PG8_STAGE(PG8_SA(0, 0), cA, voffA); PG8_STAGE(PG8_SB(0, 1), cB + hstepB, voffB); PG8_STAGE(PG8_SA(0, 1), cA + hstepA, voffA);
        if (wr == 1) PG8_BAR;
        PG8_WAIT_V(4); PG8_BAR;
        PG8_STAGE(PG8_SB(1, 0), cB + kstep, voffB); PG8_STAGE(PG8_SA(1, 0), cA + kstep, voffA); PG8_STAGE(PG8_SB(1, 1), cB + hstepB + kstep, voffB);
        PG8_WAIT_V(6); PG8_BAR;
    }
    for (;;) {
        const bool has_next = S.next(ui + 1, nxt);
        const char* nA = has_next ? (const char*)g.A + (size_t)nxt.pm * tstepA + g.acol(nxt.pn) : cA; const char* nB = has_next ? (const char*)g.Bt + (size_t)nxt.pn * tstepB + g.bcol(nxt.pm) : cB;
        for (int t = 0; t < nt; t += 2) {
            const bool last = (t == nt - 2);
            const char* a1 = cA + (size_t)(t + 1) * kstep;
            const char* a2 = last ? nA : cA + (size_t)(t + 2) * kstep; const char* b2 = last ? nB : cB + (size_t)(t + 2) * kstep;
            const char* a3 = a2 + kstep; const char* b3 = b2 + kstep;
            if (last && has_next) S.a_ready(nxt);
            if constexpr (SP2) {
            PG8_LDB(B0, 0, 0); PG8_LDB(B1, 0, 1); PG8_SCHED; PG8_LDA(At, 0, 0); PG8_STAGE(PG8_SA(1, 1), a1 + hstepA, voffA);
            PG8_WAIT_V(8); PG8_WAIT_L(0); PG8_BAR; if (PROBE && t == 0 && ui == 2) PG8_PSTAMP(2); PG8_MMA(0, 0, At, B0); PG8_MMA(0, 1, At, B1); PG8_BAR; PG8_SCHED;
            PG8_LDA(At, 0, 1); PG8_STAGE(PG8_SB(0, 0), b2, voffB); PG8_STAGE(PG8_SB(0, 1), b2 + hstepB, voffB); PG8_STAGE(PG8_SA(0, 0), a2, voffA);
            PG8_WAIT_V(8); PG8_WAIT_L(0); PG8_BAR; PG8_MMA(1, 0, At, B0); PG8_MMA(1, 1, At, B1); PG8_BAR; PG8_SCHED;
            PG8_LDB(B0, 1, 0); PG8_LDB(B1, 1, 1); PG8_SCHED; PG8_LDA(At, 1, 0); PG8_STAGE(PG8_SA(0, 1), a2 + hstepA, voffA);
            PG8_WAIT_V(8); PG8_WAIT_L(0); PG8_BAR; PG8_MMA(0, 0, At, B0); PG8_MMA(0, 1, At, B1); PG8_BAR; PG8_SCHED;
            PG8_LDA(At, 1, 1); PG8_STAGE(PG8_SB(1, 0), b3, voffB); PG8_STAGE(PG8_SB(1, 1), b3 + hstepB, voffB); PG8_STAGE(PG8_SA(1, 0), a3, voffA);
            PG8_WAIT_V(8); PG8_WAIT_L(0); PG8_BAR; PG8_MMA(1, 0, At, B0); PG8_MMA(1, 1, At, B1); PG8_BAR; PG8_SCHED;
            } else {
            PG8_LDB(B0, 0, 0); PG8_SCHED; PG8_LDA(At, 0, 0); PG8_STAGE(PG8_SA(1, 1), a1 + hstepA, voffA);
            PG8_WAIT_L(8); PG8_BAR; PG8_WAIT_L(0); PG8_MMA(0, 0, At, B0); PG8_BAR; PG8_SCHED;
            PG8_LDB(B1, 0, 1); PG8_STAGE(PG8_SB(0, 0), b2, voffB);
            PG8_BAR; PG8_WAIT_L(0); PG8_MMA(0, 1, At, B1); PG8_BAR;
            PG8_LDA(At, 0, 1); PG8_STAGE(PG8_SA(0, 0), a2, voffA);
            PG8_BAR; PG8_WAIT_L(0); PG8_MMA(1, 0, At, B0); PG8_BAR; PG8_SCHED;
            PG8_STAGE(PG8_SB(0, 1), b2 + hstepB, voffB);
            PG8_WAIT_V(6); PG8_BAR; PG8_MMA(1, 1, At, B1); PG8_BAR;
            PG8_LDB(B0, 1, 0); PG8_SCHED; PG8_LDA(At, 1, 0); PG8_STAGE(PG8_SA(0, 1), a2 + hstepA, voffA);
            PG8_WAIT_L(8); PG8_BAR; PG8_WAIT_L(0); PG8_MMA(0, 0, At, B0); PG8_BAR; PG8_SCHED;
            PG8_LDB(B1, 1, 1); PG8_STAGE(PG8_SB(1, 0), b3, voffB);
            PG8_BAR; PG8_WAIT_L(0); PG8_MMA(0, 1, At, B1); PG8_BAR;
            PG8_LDA(At, 1, 1); PG8_STAGE(PG8_SA(1, 0), a3, voffA);
            PG8_BAR; PG8_WAIT_L(0); PG8_MMA(1, 0, At, B0); PG8_BAR; PG8_SCHED;
            PG8_STAGE(PG8_SB(1, 1), b3 + hstepB, voffB);
            PG8_WAIT_V(6); PG8_BAR; PG8_MMA(1, 1, At, B1); PG8_BAR;
            }
        }
        if (PROBE && ui == 1) PG8_PSTAMP(0); if (PROBE && ui == 2) PG8_PSTAMP(3);
        if constexpr (ALIGN_EPI) { if (wr == 0) PG8_BAR; }
        if constexpr (!Epi::AFTER_DRAIN) { E(acc, cur, wr, wc, fr, fq); S.done(cur); }
        if (PROBE && ui == 1) PG8_PSTAMP(1); if (PROBE && ui == 2) PG8_PSTAMP(4);
        if (!has_next) break;
#pragma unroll
        for (int a = 0; a < 2; ++a)
#pragma unroll
            for (int b = 0; b < 2; ++b)
#pragma unroll
                for (int m = 0; m < 4; ++m)
#pragma unroll
                    for (int n = 0; n < 2; ++n) acc[a][b][m][n] = (f32x4){0.f, 0.f, 0.f, 0.f};
        cur = nxt; cA = nA; cB = nB; ++ui;
        if constexpr (ALIGN_EPI) { if (wr == 1) PG8_BAR; }
    }
    PG8_WAIT_V(0);
    if constexpr (!ALIGN_EPI) { if (wr == 0) PG8_BAR; }
    PG8_BAR;
    if constexpr (Epi::AFTER_DRAIN) { E.fused(acc, cur, wr, wc, fr, fq, lds, wid, lane); S.done(cur); }
#undef PG8_PSTAMP
#undef PG8_SA
#undef PG8_SB
#undef PG8_STAGE
#undef PG8_LDA
#undef PG8_LDB
#undef PG8_MMA
#undef PG8_WAIT_V
#undef PG8_WAIT_L
#undef PG8_BAR
#undef PG8_SCHED
}
}

constexpr int NWAVES = 8;
constexpr int DM = 4096, EI = 8192, BATCH = 4, SEQ = 2048, MTOK = BATCH * SEQ;
constexpr int CHUNK = 128, NHEAD = 16, HDIM = EI / NHEAD;
constexpr int NGRP = 4, GWID = EI / NGRP;
constexpr float EPS = 1e-6f;
constexpr int NST = 64;
constexpr int NPH = 10;
static_assert(MTOK % 256 == 0 && SEQ % CHUNK == 0 && SEQ % 256 == 0, "tiling");

constexpr size_t MiB = 1u << 20;
constexpr size_t WS_CTL = 0, CTL_ZERO_BYTES = 64 * 1024;
constexpr size_t WS_W1UZ = 1 * MiB;
constexpr size_t WS_W1V  = WS_W1UZ + (size_t)2 * EI * DM * 2;
constexpr size_t WS_W2   = WS_W1V + (size_t)EI * DM * 2;
constexpr size_t WS_W3   = WS_W2 + (size_t)DM * EI * 2;
constexpr size_t WS_W4   = WS_W3 + (size_t)2 * EI * DM * 2;
constexpr size_t WS_W5   = WS_W4 + (size_t)EI * GWID * 2;
constexpr size_t WS_H    = WS_W5 + (size_t)DM * EI * 2;
constexpr size_t WS_B0   = WS_H + (size_t)MTOK * DM * 2;
constexpr size_t WS_B1   = WS_B0 + (size_t)MTOK * EI * 2;
constexpr size_t WS_B2   = WS_B1 + (size_t)MTOK * EI * 2;
constexpr size_t WS_M    = WS_B2 + (size_t)MTOK * EI * 2;
constexpr size_t WS_ST   = WS_M + (size_t)MTOK * DM * 2;
constexpr size_t WS_DBG  = WS_ST + (size_t)NST * MTOK * 8;
constexpr size_t WS_X1B  = WS_DBG + (size_t)MTOK * 8;
constexpr size_t WS_END  = WS_X1B + (size_t)MTOK * DM * 2;
constexpr size_t WS_W3P = WS_W3 + (size_t)EI * DM * 2;
constexpr size_t WS_WC = WS_W1V, WS_Y1 = WS_W1UZ, WS_PH = WS_B1;
static_assert(WS_B2 == WS_B1 + (size_t)MTOK * EI * 2 && (size_t)NGRP * MTOK * DM * 2 <= 2 * (size_t)MTOK * EI * 2, "PH overlays B1|B2");
constexpr int CW_BAR = 4096;

constexpr int RING_OFF = 0, RING_BYTES = 131072;
constexpr int LDSCTL_OFF = RING_BYTES, MISC_OFF = LDSCTL_OFF + 320;
constexpr int LDS_BYTES = 147456;
static_assert(MISC_OFF + 128 <= LDS_BYTES, "LDS map");

#define GAS __attribute__((address_space(1)))
#define LAS __attribute__((address_space(3)))
typedef unsigned short bf16;
typedef unsigned v4u __attribute__((ext_vector_type(4)));
typedef float f32x4 __attribute__((ext_vector_type(4)));
typedef short bf16x8 __attribute__((ext_vector_type(8)));
typedef GAS unsigned gu32;
typedef GAS unsigned long long gu64;
#define RLX_AGENT __ATOMIC_RELAXED, __HIP_MEMORY_SCOPE_AGENT
#define LDS_WAIT() asm volatile("s_waitcnt lgkmcnt(0)" ::: "memory")
#define VM_WAIT() asm volatile("s_waitcnt vmcnt(0)" ::: "memory")
__device__ __forceinline__ unsigned long long rt() { return __builtin_amdgcn_s_memrealtime(); }
__device__ __forceinline__ unsigned f2bf(float f) { unsigned u = __builtin_bit_cast(unsigned, f); return (u + 0x7fffu + ((u >> 16) & 1u)) >> 16; }
__device__ __forceinline__ unsigned pk2(float lo, float hi) { return f2bf(lo) | (f2bf(hi) << 16); }

#define XB_TMO      128
#define XB_XCNT(j)  (256  + 64 * (j))
#define XB_XSUB(j)  (1280 + 64 * (j))
#define XB_XGEN(j)  (2304 + 64 * (j))
#define XB_TOP      3328
#define XB_TOPGEN   3392
#define XCD_BAR_WORDS 3456
#define XB_SPIN_CAP (1u << 18)

__device__ __forceinline__ unsigned xb_ld(unsigned* p)              { return __hip_atomic_load(p, __ATOMIC_RELAXED, __HIP_MEMORY_SCOPE_AGENT); }
__device__ __forceinline__ unsigned xb_add(unsigned* p, unsigned v) { return __hip_atomic_fetch_add(p, v, __ATOMIC_RELAXED, __HIP_MEMORY_SCOPE_AGENT); }
__device__ __forceinline__ unsigned xb_xcc_id() { return (unsigned)__builtin_amdgcn_s_getreg((3 << 11) | 20) & 0xFu; }
#define XB_SPIN(cond, bar) do { unsigned _sp = 0; while (cond) { __builtin_amdgcn_s_sleep(1); \
    if ((++_sp & 255u) == 0u) { if (xb_ld(&(bar)[XB_TMO])) break; if (_sp > XB_SPIN_CAP) { atomicAdd(&(bar)[XB_TMO], 1u); break; } } } } while (0)

struct XcdBarrier {
    unsigned* bar; unsigned x;
    volatile LAS unsigned* st;
};

__device__ __forceinline__ XcdBarrier xcd_barrier_post(unsigned* bar, volatile LAS unsigned* st) {
    XcdBarrier b; b.bar = bar; b.x = xb_xcc_id(); b.st = st;
    if (threadIdx.x == 0) (void)xb_add(&bar[XB_XCNT(b.x)], 1u);
    return b;
}
__device__ __forceinline__ void xcd_barrier_complete(unsigned* bar, unsigned x, unsigned& nloc, unsigned& nx) {
    const unsigned G = gridDim.x * gridDim.y * gridDim.z;
    unsigned sum, cnt, mine, sp = 0u;
    for (;;) {
        sum = 0u; cnt = 0u; mine = 0u;
#pragma unroll
        for (unsigned j = 0; j < 16; ++j) { const unsigned c = xb_ld(&bar[XB_XCNT(j)]); sum += c; cnt += (c > 0u) ? 1u : 0u; mine = (j == x) ? c : mine; }
        if (sum == G) break;
        __builtin_amdgcn_s_sleep(1);
        if ((++sp & 255u) == 0u) { if (xb_ld(&bar[XB_TMO])) break; if (sp > XB_SPIN_CAP) { atomicAdd(&bar[XB_TMO], 1u); break; } }
    }
    nloc = mine > 0u ? mine : 1u; nx = cnt > 0u ? cnt : 1u;
}

__device__ __forceinline__ void xcd_barrier(const XcdBarrier& b) {
    asm volatile("s_waitcnt vmcnt(0)" ::: "memory");
    __syncthreads();
    if (threadIdx.x == 0) {
        unsigned* bar = b.bar;
        __builtin_amdgcn_s_waitcnt(0);
        unsigned nloc = b.st[0], nx = b.st[1];
        if (nloc == 0u) { xcd_barrier_complete(bar, b.x, nloc, nx); b.st[0] = nloc; b.st[1] = nx; }
        const unsigned old = xb_add(&bar[XB_XSUB(b.x)], 1u);
        const unsigned gen = old / nloc;
        if (old + 1u == (gen + 1u) * nloc) {
            __builtin_amdgcn_fence(__ATOMIC_RELEASE, "agent");
            asm volatile("s_waitcnt vmcnt(0)" ::: "memory");
            const unsigned og = xb_add(&bar[XB_TOP], 1u);
            const unsigned tg = og / nx;
            if (og + 1u == (tg + 1u) * nx) xb_add(&bar[XB_TOPGEN], 1u);
            else XB_SPIN(xb_ld(&bar[XB_TOPGEN]) == tg, bar);
            __builtin_amdgcn_fence(__ATOMIC_ACQUIRE, "agent");
            xb_add(&bar[XB_XGEN(b.x)], 1u);
            asm volatile("s_waitcnt vmcnt(0)" ::: "memory");
        } else {
            XB_SPIN(xb_ld(&bar[XB_XGEN(b.x)]) == gen, bar);
            __builtin_amdgcn_fence(__ATOMIC_ACQUIRE, "agent");
            asm volatile("s_waitcnt vmcnt(0)" ::: "memory");
        }
    }
    __syncthreads();
}

enum { IN_X = 0, IN_PRE, IN_POST, IN_AWIN, IN_ALNG, IN_ALNB, IN_AWS, IN_ABS, IN_AWOUT, IN_BWIN, IN_BWGRP, IN_BBGRP, IN_BSCALE, IN_BWOUT, N_IN };
struct Args { const float* in[N_IN]; float* out; unsigned char* ws; int ph_lo, ph_hi; };
struct Frame {
    LAS unsigned char* lds;
    volatile LAS unsigned* MISC;
    gu32* ctl;
    int tid, lane, wave;
    int vcu, G;
};
__device__ __forceinline__ float wave_sum(float v) {
#pragma unroll
    for (int o = 1; o < 64; o <<= 1) v += __shfl_xor(v, o);
    return v;
}
__device__ __forceinline__ float dot4(f32x4 a, f32x4 b) { return (a.x * b.x + a.y * b.y) + (a.z * b.z + a.w * b.w); }
using pg8::cvt_pk_bf16; using pg8::pack8; using pg8::unpk_lo; using pg8::unpk_hi; using pg8::u32x4; using pg8::f32x2;

struct CvDesc { const float* src; bf16* dst; int ldw, K, plain; };
__device__ __forceinline__ CvDesc cv_make(const float* W, int ldw, int K, int n0, bf16* WT, int drow0, int k0, int lane) {
    const int kq = lane & 7, nq = lane >> 3; CvDesc d; d.src = W + (size_t)(k0 + 8 * kq) * ldw + n0 + 4 * nq; d.dst = WT + (size_t)(drow0 + 4 * nq) * K + k0 + 8 * kq; d.ldw = ldw; d.K = K; d.plain = 0; return d; }
__device__ __forceinline__ CvDesc cv_make_plain(const float* W, int ldw, bf16* D, int ldd, int row0, int col0, int lane) {
    CvDesc d; d.src = W + (size_t)row0 * ldw + col0 + 8 * lane; d.dst = D + (size_t)row0 * ldd + col0 + 8 * lane; d.ldw = ldw; d.K = ldd; d.plain = 1; return d; }
__device__ __forceinline__ void cv_load(const CvDesc& d, f32x4 (&r)[8]) {
    const GAS f32x4* src = (const GAS f32x4*)d.src;
    if (d.plain) {
#pragma unroll
        for (int j = 0; j < 4; ++j) { r[2 * j] = __builtin_nontemporal_load(src + (size_t)j * (d.ldw / 4)); r[2 * j + 1] = __builtin_nontemporal_load(src + (size_t)j * (d.ldw / 4) + 1); }
    } else {
#pragma unroll
        for (int j = 0; j < 8; ++j) r[j] = __builtin_nontemporal_load(src + (size_t)j * (d.ldw / 4));
    }
}
__device__ __forceinline__ unsigned wq(unsigned w) { if (WDROP == 0) return w; constexpr unsigned h = (1u << (WDROP > 0 ? WDROP - 1 : 0)) * 0x00010001u, m = ~(((1u << WDROP) - 1u) * 0x00010001u); return (w + h) & m; }
__device__ __forceinline__ v4u wq4(v4u o) { o.x = wq(o.x); o.y = wq(o.y); o.z = wq(o.z); o.w = wq(o.w); return o; }
__device__ __forceinline__ void cv_store(const CvDesc& d, const f32x4 (&r)[8]) {
    if (d.plain) {
#pragma unroll
        for (int j = 0; j < 4; ++j) __builtin_nontemporal_store(wq4(pack8(r[2 * j], r[2 * j + 1])), (GAS v4u*)(d.dst + (size_t)j * d.K));
    } else {
#pragma unroll
        for (int e = 0; e < 4; ++e) { v4u o; o.x = cvt_pk_bf16(r[0][e], r[1][e]); o.y = cvt_pk_bf16(r[2][e], r[3][e]); o.z = cvt_pk_bf16(r[4][e], r[5][e]); o.w = cvt_pk_bf16(r[6][e], r[7][e]);
            __builtin_nontemporal_store(wq4(o), (GAS v4u*)(d.dst + (size_t)e * d.K)); }
    }
}
__device__ __forceinline__ void rms_row_to_bf16(const float* xrow, const float* g, bf16* orow, int lane) {
    const GAS f32x4* xr = (const GAS f32x4*)xrow + lane;
    f32x4 v[16]; float s = 0.f;
#pragma unroll
    for (int j = 0; j < 16; ++j) { v[j] = xr[64 * j]; s += dot4(v[j], v[j]); }
    const float rstd = 1.f / sqrtf(wave_sum(s) * (1.f / DM) + EPS);
    const GAS f32x4* gr = (const GAS f32x4*)g + lane;
    GAS unsigned long long* o8 = (GAS unsigned long long*)orow + lane;
#pragma unroll
    for (int j = 0; j < 16; ++j) { const f32x4 o = v[j] * rstd * gr[64 * j];
        o8[64 * j] = (unsigned long long)cvt_pk_bf16(o.x, o.y) | ((unsigned long long)cvt_pk_bf16(o.z, o.w) << 32); }
}
constexpr int CI0 = (DM / 64) * (2 * EI / 32), CI1 = (DM / 64) * (EI / 32), CI2 = (EI / 64) * (DM / 32), CI3 = (DM / 64) * (2 * EI / 32)  , CI4G = (GWID / 64) * (GWID / 32), CI4 = NGRP * CI4G, CI5 = CI2;
constexpr int CSET_A = 0, CNT_A = CI0 + CI1, CSET_B = CNT_A, CNT_B = CI2 + CI3, CSET_C = CSET_B + CNT_B, CNT_C = CI4 + CI5;
__device__ __forceinline__ CvDesc conv_desc(const Args& a, int it, int lane) {
    int r = it;
    if (r < CI0) { constexpr int nbk = 2 * EI / 32; const int kb = r / nbk, nb = r % nbk, t = nb >> 3, jb = nb & 7;
        const int n0 = (jb < 4) ? 128 * t + 32 * jb : 2 * EI + 128 * t + 32 * (jb - 4);
        return cv_make(a.in[IN_AWIN], 3 * EI, DM, n0, (bf16*)(a.ws + WS_W1UZ), 32 * nb, 64 * kb, lane); } r -= CI0;
    if (r < CI1) { constexpr int nbk = EI / 32; const int kb = r / nbk, nb = r % nbk;
        return cv_make(a.in[IN_AWIN], 3 * EI, DM, EI + 32 * nb, (bf16*)(a.ws + WS_W1V), 32 * nb, 64 * kb, lane); } r -= CI1;
    if (r < CI2) { constexpr int nbk = DM / 32; const int kb = r / nbk, nb = r % nbk;
        return cv_make(a.in[IN_AWOUT], DM, EI, 32 * nb, (bf16*)(a.ws + WS_W2), 32 * nb, 64 * kb, lane); } r -= CI2;
#if WCOMB
    if (r < CI3 / 2) { constexpr int nbk = EI / 32; const int kb = r / nbk, nb = r % nbk;
        return cv_make(a.in[IN_BWIN], 2 * EI, DM, EI + 32 * nb, (bf16*)(a.ws + WS_W3), 32 * nb, 64 * kb, lane); }
    if (r < CI3) { r -= CI3 / 2; constexpr int nseg = EI / 512; const int rq = r / nseg, sg = r % nseg;
        return cv_make_plain(a.in[IN_BWIN], 2 * EI, (bf16*)(a.ws + WS_W3P), EI, 4 * rq, 512 * sg, lane); } r -= CI3;
#else
    if (r < CI3) { constexpr int nbk = 2 * EI / 32; const int kb = r / nbk, nb = r % nbk;
        return cv_make(a.in[IN_BWIN], 2 * EI, DM, 32 * nb, (bf16*)(a.ws + WS_W3), 32 * nb, 64 * kb, lane); } r -= CI3;
#endif
    if (r < CI4) { constexpr int nbk = GWID / 32; const int g = r / CI4G; r -= g * CI4G; const int kb = r / nbk, nb = r % nbk;
        return cv_make(a.in[IN_BWGRP] + (size_t)g * GWID * GWID, GWID, GWID, 32 * nb, (bf16*)(a.ws + WS_W4) + (size_t)g * GWID * GWID, 32 * nb, 64 * kb, lane); } r -= CI4;
    { constexpr int nbk = DM / 32; const int kb = r / nbk, nb = r % nbk;
        return cv_make(a.in[IN_BWOUT], DM, EI, 32 * nb, (bf16*)(a.ws + WS_W5), 32 * nb, 64 * kb, lane); }
}
__device__ __forceinline__ void conv_rounds(const Args& a, Frame& F, int base, int count, int i_lo, int i_hi, bool rev = false) {
    const int gw = F.vcu * NWAVES + F.wave, NGW = F.G * NWAVES;
    int i = i_lo;
    if (i + 1 < i_hi && gw + (i + 1) * NGW < count) {
        CvDesc d0 = conv_desc(a, base + (rev ? count - 1 - (gw + i * NGW) : gw + i * NGW), F.lane), d1 = conv_desc(a, base + (rev ? count - 1 - (gw + (i + 1) * NGW) : gw + (i + 1) * NGW), F.lane);
        f32x4 r0[8], r1[8]; cv_load(d0, r0); cv_load(d1, r1); i += 2;
        for (; i + 1 < i_hi && gw + (i + 1) * NGW < count; i += 2) {
            const CvDesc e0 = conv_desc(a, base + (rev ? count - 1 - (gw + i * NGW) : gw + i * NGW), F.lane), e1 = conv_desc(a, base + (rev ? count - 1 - (gw + (i + 1) * NGW) : gw + (i + 1) * NGW), F.lane);
            f32x4 q0[8], q1[8]; cv_load(e0, q0); cv_load(e1, q1);
            cv_store(d0, r0); cv_store(d1, r1);
            d0 = e0; d1 = e1;
#pragma unroll
            for (int j = 0; j < 8; ++j) { r0[j] = q0[j]; r1[j] = q1[j]; }
        }
        cv_store(d0, r0); cv_store(d1, r1);
    }
    for (; i < i_hi; ++i) { const int it = gw + i * NGW; if (it < count) { const CvDesc d = conv_desc(a, base + (rev ? count - 1 - it : it), F.lane); f32x4 r[8]; cv_load(d, r); cv_store(d, r); } }
}
__device__ __forceinline__ int conv_nrounds(const Frame& F, int count) { const int NGW = F.G * NWAVES; return (count + NGW - 1) / NGW; }
__device__ __forceinline__ int conv_npre(const Frame& F, int count) { return (int)(((long)blockIdx.x * conv_nrounds(F, count)) / F.G); }
__device__ __forceinline__ void p0_prologue(const Args& a, Frame& F) {
    const int gw = F.vcu * NWAVES + F.wave, NGW = F.G * NWAVES, lane = F.lane;
#if !STAGGER
    conv_rounds(a, F, CSET_A, CNT_A + CNT_B + CNT_C, 0, conv_nrounds(F, CNT_A + CNT_B + CNT_C), true);
#else
    conv_rounds(a, F, CSET_A, CNT_A, 0, conv_nrounds(F, CNT_A));
#endif
    for (int m = gw; m < MTOK; m += NGW) rms_row_to_bf16(a.in[IN_X] + (size_t)m * DM, a.in[IN_PRE], (bf16*)(a.ws + WS_H) + (size_t)m * DM, lane);
}

__device__ __forceinline__ void sgu_phase(const Args& a, Frame& F) {
    constexpr int WP_PITCH = 272, WP_BYTES = 128 * WP_PITCH;
    constexpr int OFF_CV = 2 * WP_BYTES, OFF_MU = OFF_CV + 2 * 3 * 128 * 4, OFF_RS = OFF_MU + 512, OFF_PART = OFF_RS + 512, OFF_GB = OFF_PART + 4096;
    static_assert(OFF_GB + 2 * 2 * HDIM * 4 <= RING_BYTES, "sgu LDS");
    LAS unsigned char* L = F.lds + RING_OFF;
    LAS float* MU = (LAS float*)(L + OFF_MU); LAS float* RS = (LAS float*)(L + OFF_RS); LAS float* PART = (LAS float*)(L + OFF_PART);
    const float* ST = (const float*)(a.ws + WS_ST); const bf16* GVT = (const bf16*)(a.ws + WS_B1); const bf16* UZ = (const bf16*)(a.ws + WS_B0); bf16* Y = (bf16*)(a.ws + WS_B2);
    const float* lng = a.in[IN_ALNG]; const float* lnb = a.in[IN_ALNB]; const float* wsp = a.in[IN_AWS]; const float* bsv = a.in[IN_ABS];
    const int tid = F.tid, lane = F.lane, wave = F.wave, fr = lane & 15, fq = lane >> 4;
    for (int unit = blockIdx.x; unit < (MTOK / CHUNK) * 4; unit += F.G) {
        const int ck = unit >> 2, hg = unit & 3, R0 = ck * CHUNK;
        { const int r = tid & 127, q = tid >> 7; float s = 0.f, ss = 0.f;
#pragma unroll
            for (int j = 0; j < NST / 4; ++j) { const f32x2 p = *(const GAS f32x2*)(ST + ((size_t)(q * (NST / 4) + j) * MTOK + R0 + r) * 2); s += p.x; ss += p.y; }
            PART[(q * 128 + r) * 2] = s; PART[(q * 128 + r) * 2 + 1] = ss; }
        __syncthreads();
        if (tid < 128) { float s = 0.f, ss = 0.f;
#pragma unroll
            for (int q = 0; q < 4; ++q) { s += PART[(q * 128 + tid) * 2]; ss += PART[(q * 128 + tid) * 2 + 1]; }
            const float mean = s * (1.f / EI); float var = ss * (1.f / EI) - mean * mean; var = var > 0.f ? var : 0.f;
            MU[tid] = mean; RS[tid] = 1.f / sqrtf(var + EPS); }
        __syncthreads();
        for (int hh = 0; hh < 4; ++hh) {
            const int h = hg * 4 + hh, buf = hh & 1;
            LAS unsigned char* WP = L + buf * WP_BYTES; LAS float* CV = (LAS float*)(L + OFF_CV) + buf * 384;
            { const int t = tid >> 2, part = tid & 3, s0 = 32 * part;
                const GAS f32x4* wrow = (const GAS f32x4*)(wsp + ((size_t)h * CHUNK + t) * CHUNK + s0);
                float c1 = 0.f, c2 = 0.f;
#pragma unroll
                for (int i = 0; i < 4; ++i) {
                    const f32x4 wa = wrow[2 * i], wb = wrow[2 * i + 1];
                    const f32x4 ra = *(const LAS f32x4*)(RS + s0 + 8 * i), rb = *(const LAS f32x4*)(RS + s0 + 8 * i + 4);
                    const f32x4 ma = *(const LAS f32x4*)(MU + s0 + 8 * i), mb = *(const LAS f32x4*)(MU + s0 + 8 * i + 4);
                    f32x4 ca, cb;
#pragma unroll
                    for (int e = 0; e < 4; ++e) { ca[e] = (s0 + 8 * i + e <= t) ? wa[e] : 0.f; cb[e] = (s0 + 8 * i + 4 + e <= t) ? wb[e] : 0.f; }
                    c2 += (ca.x + ca.y) + (ca.z + ca.w) + (cb.x + cb.y) + (cb.z + cb.w);
                    const u32x4 pk = pack8(ca * ra, cb * rb);
                    c1 += dot4(unpk_lo(pk), ma) + dot4(unpk_hi(pk), mb);
                    *(LAS u32x4*)(WP + t * WP_PITCH + (s0 + 8 * i) * 2) = pk; }
                c1 += __shfl_xor(c1, 1); c1 += __shfl_xor(c1, 2); c2 += __shfl_xor(c2, 1); c2 += __shfl_xor(c2, 2);
                if (part == 0) { CV[t] = c1; CV[128 + t] = c2; CV[256 + t] = bsv[h * CHUNK + t]; }
                LAS float* GB = (LAS float*)(L + OFF_GB) + buf * 2 * HDIM; GB[tid] = lng[h * HDIM + tid]; GB[HDIM + tid] = lnb[h * HDIM + tid]; }
            __syncthreads();
            const int chb = h * HDIM + wave * 64;
            bf16x8 Gf[4][4];
#pragma unroll
            for (int nd = 0; nd < 4; ++nd) { const int ch = chb + 32 * (nd >> 1) + 8 * (fr >> 2) + 4 * (nd & 1) + (fr & 3);
#pragma unroll
                for (int ks = 0; ks < 4; ++ks) Gf[nd][ks] = *(const GAS bf16x8*)(GVT + (size_t)ch * MTOK + R0 + 32 * ks + 8 * fq); }
            const LAS float* GBw = (const LAS float*)(L + OFF_GB) + buf * 2 * HDIM + wave * 64 + 8 * fq;
#pragma unroll 1
            for (int th = 0; th < 2; ++th) {
                u32x4 uzv[4][2];
#pragma unroll
                for (int mq = 0; mq < 4; ++mq)
#pragma unroll
                    for (int p = 0; p < 2; ++p) uzv[mq][p] = *(const GAS u32x4*)(UZ + (size_t)(R0 + 16 * (4 * th + mq) + fr) * EI + chb + 32 * p + 8 * fq);
                f32x4 acc[4][4];
#pragma unroll
                for (int nd = 0; nd < 4; ++nd)
#pragma unroll
                    for (int mq = 0; mq < 4; ++mq) acc[nd][mq] = (f32x4){0.f, 0.f, 0.f, 0.f};
#pragma unroll
                for (int mq = 0; mq < 4; ++mq) { const int mt = 4 * th + mq;
#pragma unroll
                    for (int ks = 0; ks < 4; ++ks) if (ks <= mt / 2) {
                        const bf16x8 wf = *(const LAS bf16x8*)(WP + (16 * mt + fr) * WP_PITCH + (32 * ks + 8 * fq) * 2);
#pragma unroll
                        for (int nd = 0; nd < 4; ++nd) acc[nd][mq] = __builtin_amdgcn_mfma_f32_16x16x32_bf16(Gf[nd][ks], wf, acc[nd][mq], 0, 0, 0); } }
#pragma unroll
                for (int mq = 0; mq < 4; ++mq) { const int t = 16 * (4 * th + mq) + fr; const float c1 = CV[t], c2 = CV[128 + t], bs = CV[256 + t];
#pragma unroll
                    for (int p = 0; p < 2; ++p) { const size_t off = (size_t)(R0 + t) * EI + chb + 32 * p + 8 * fq;
                        const u32x4 uz = uzv[mq][p];
                        const f32x4 lg0 = *(const LAS f32x4*)(GBw + 32 * p), lg1 = *(const LAS f32x4*)(GBw + 32 * p + 4), lb0 = *(const LAS f32x4*)(GBw + HDIM + 32 * p), lb1 = *(const LAS f32x4*)(GBw + HDIM + 32 * p + 4);
                        const f32x4 sv0 = lg0 * (acc[2 * p][mq] - c1) + (lb0 * c2 + bs), sv1 = lg1 * (acc[2 * p + 1][mq] - c1) + (lb1 * c2 + bs);
                        *(GAS u32x4*)(Y + off) = pack8(unpk_lo(uz) * sv0, unpk_hi(uz) * sv1); } }
            }
        }
        __syncthreads();
    }
}

template <bool FINAL>
__device__ __forceinline__ void norm_phase(const bf16* M, const float* xin, float* xout, const float* gpost, const float* gpre, bf16* H, bf16* x1b, Frame& F) {
    const int gw = F.vcu * NWAVES + F.wave, NGW = F.G * NWAVES, lane = F.lane;
    for (int m = gw; m < MTOK; m += NGW) {
        const GAS u32x4* mr = (const GAS u32x4*)(M + (size_t)m * DM) + lane;
        u32x4 mv[8]; float ss = 0.f;
#pragma unroll
        for (int j = 0; j < 8; ++j) { mv[j] = mr[64 * j]; const f32x4 lo = unpk_lo(mv[j]), hi = unpk_hi(mv[j]); ss += dot4(lo, lo) + dot4(hi, hi); }
        const float rm = 1.f / sqrtf(wave_sum(ss) * (1.f / DM) + EPS);
        f32x4 x1[16]; float s2 = 0.f;
#pragma unroll
        for (int j = 0; j < 8; ++j) { const size_t e0 = (size_t)8 * (lane + 64 * j);
            f32x4 xa, xb;
            if (FINAL && x1b) { const u32x4 xp = *(const GAS u32x4*)(x1b + (size_t)m * DM + e0); xa = unpk_lo(xp); xb = unpk_hi(xp); }
            else { xa = *(const GAS f32x4*)(xin + (size_t)m * DM + e0); xb = *(const GAS f32x4*)(xin + (size_t)m * DM + e0 + 4); }
            const f32x4 ga = *(const GAS f32x4*)(gpost + e0), gb = *(const GAS f32x4*)(gpost + e0 + 4);
            x1[2 * j] = xa + unpk_lo(mv[j]) * rm * ga; x1[2 * j + 1] = xb + unpk_hi(mv[j]) * rm * gb;
            if (!FINAL && x1b) { const u32x4 xp = pack8(x1[2 * j], x1[2 * j + 1]); *(GAS u32x4*)(x1b + (size_t)m * DM + e0) = xp; x1[2 * j] = unpk_lo(xp); x1[2 * j + 1] = unpk_hi(xp); }
            else { *(GAS f32x4*)(xout + (size_t)m * DM + e0) = x1[2 * j]; *(GAS f32x4*)(xout + (size_t)m * DM + e0 + 4) = x1[2 * j + 1]; }
            s2 += dot4(x1[2 * j], x1[2 * j]) + dot4(x1[2 * j + 1], x1[2 * j + 1]); }
        if constexpr (!FINAL) {
            const float rx = 1.f / sqrtf(wave_sum(s2) * (1.f / DM) + EPS);
#pragma unroll
            for (int j = 0; j < 8; ++j) { const size_t e0 = (size_t)8 * (lane + 64 * j);
                const f32x4 ga = *(const GAS f32x4*)(gpre + e0), gb = *(const GAS f32x4*)(gpre + e0 + 4);
                *(GAS u32x4*)(H + (size_t)m * DM + e0) = pack8(x1[2 * j] * rx * ga, x1[2 * j + 1] * rx * gb); }
        }
    }
}

template <int W>
__device__ __forceinline__ void pool_unit(const bf16* P, bf16* O, int R0, int c0) {
    const int tseq0 = R0 & (SEQ - 1);
    f32x4 Sa = (f32x4){0.f, 0.f, 0.f, 0.f}, Sb = Sa; u32x4 ring[W];
#pragma unroll
    for (int j = 0; j < W; ++j) {
        u32x4 v = (u32x4){0u, 0u, 0u, 0u};
        if (tseq0 - W + j >= 0) v = *(const GAS u32x4*)(P + (size_t)(R0 - W + j) * EI + c0);
        ring[j] = v; if (j >= 1) { Sa += unpk_lo(v); Sb += unpk_hi(v); } }
    for (int t = 0; t < 64; t += W) {
#pragma unroll
        for (int j = 0; j < W; ++j) {
            const size_t off = (size_t)(R0 + t + j) * EI + c0;
            const u32x4 cur = *(const GAS u32x4*)(P + off);
            const f32x4 ca = unpk_lo(cur), cb = unpk_hi(cur);
            Sa += ca; Sb += cb;
            const int pos = tseq0 + t + j + 1; const float inv = 1.f / (float)(pos < W ? pos : W);
            *(GAS u32x4*)(O + off) = pack8(Sa * inv - ca, Sb * inv - cb);
            ring[j] = cur;
            const u32x4 old = ring[(j + 1) % W]; Sa -= unpk_lo(old); Sb -= unpk_hi(old);
        }
    }
}
__device__ __forceinline__ void pool_phase(const Args& a, Frame& F) {
    const bf16* P = (const bf16*)(a.ws + WS_B1); bf16* O = (bf16*)(a.ws + WS_B2);
    const int gw = F.vcu * NWAVES + F.wave, NGW = F.G * NWAVES;
    for (int wu = gw; wu < (MTOK / 64) * (EI / 512); wu += NGW) {
        const int rb = wu >> 4, cb = wu & 15, R0 = 64 * rb, c0 = 512 * cb + 8 * F.lane, g = cb >> 2;
        if (g == 0) pool_unit<2>(P, O, R0, c0); else if (g == 1) pool_unit<4>(P, O, R0, c0); else if (g == 2) pool_unit<8>(P, O, R0, c0); else pool_unit<16>(P, O, R0, c0);
    }
}

__device__ __forceinline__ void poolh_phase(const Args& a, Frame& F) {
    const bf16* H = (const bf16*)(a.ws + WS_H); bf16* PH = (bf16*)(a.ws + WS_PH);
    const int gw = F.vcu * NWAVES + F.wave, NGW = F.G * NWAVES;
    for (int wu = gw; wu < (MTOK / 32) * (DM / 512); wu += NGW) {
        const int rb = wu >> 3, cb = wu & 7, R0 = 32 * rb, c0 = 512 * cb + 8 * F.lane, tseq0 = R0 & (SEQ - 1);
        u32x4 ring[16];
#pragma unroll
        for (int j = 0; j < 16; ++j) { u32x4 v = (u32x4){0u, 0u, 0u, 0u}; if (tseq0 - 16 + j >= 0) v = *(const GAS u32x4*)(H + (size_t)(R0 - 16 + j) * DM + c0); ring[j] = v; }
        f32x4 Sa[4], Sb[4];
#pragma unroll
        for (int g = 0; g < 4; ++g) { Sa[g] = (f32x4){0.f, 0.f, 0.f, 0.f}; Sb[g] = (f32x4){0.f, 0.f, 0.f, 0.f};
#pragma unroll
            for (int i = 1; i <= (2 << g); ++i) { Sa[g] += unpk_lo(ring[16 - i]); Sb[g] += unpk_hi(ring[16 - i]); } }
        const GAS u32x4* hp = (const GAS u32x4*)(H + (size_t)R0 * DM + c0);
        GAS u32x4* pp = (GAS u32x4*)(PH + (size_t)R0 * DM + c0);
        constexpr size_t ROWV = DM / 8, GRPV = (size_t)MTOK * DM / 8;
#pragma unroll 1
        for (int t = 0; t < 32; t += 16) {
#pragma unroll
            for (int jb = 0; jb < 16; jb += 8) {
                u32x4 nx[8];
#pragma unroll
                for (int q = 0; q < 8; ++q) nx[q] = hp[(size_t)q * ROWV];
                hp += 8 * ROWV;
#pragma unroll
                for (int q = 0; q < 8; ++q) { const int j = jb + q;
                    const u32x4 cur = nx[q];
                    const f32x4 ca = unpk_lo(cur), cb4 = unpk_hi(cur);
                    int pos = tseq0 + t + j + 1; asm volatile("" : "+s"(pos));
#pragma unroll
                    for (int g = 0; g < 4; ++g) { const int W = 2 << g; u32x4 old = ring[(j - W) & 15]; asm volatile("" : "+v"(old));
                        Sa[g] += ca - unpk_lo(old); Sb[g] += cb4 - unpk_hi(old);
                        const float inv = 1.f / (float)(pos < W ? pos : W);
                        pp[(size_t)g * GRPV] = pack8(Sa[g] * inv - ca, Sb[g] * inv - cb4); }
                    ring[j] = cur; pp += ROWV; }
                asm volatile("" ::: "memory");
            }
        }
    }
}

__global__ void __launch_bounds__(NWAVES * 64, 2) skel_fwd(Args args) {
    extern __shared__ __attribute__((aligned(16))) unsigned char lds[];
    Frame F;
    F.lds = (LAS unsigned char*)lds;
    F.MISC = (volatile LAS unsigned*)(F.lds + MISC_OFF);
    F.tid = threadIdx.x; F.lane = F.tid & 63; F.wave = __builtin_amdgcn_readfirstlane(F.tid >> 6);
    F.G = gridDim.x; { const int bx = blockIdx.x; F.vcu = (F.G % 8 == 0) ? (bx % 8) * (F.G / 8) + bx / 8 : bx; }
    unsigned char* ws = args.ws;
    F.ctl = (gu32*)(ws + WS_CTL);
    for (int u = F.tid; u < (LDS_BYTES - LDSCTL_OFF) / 4; u += NWAVES * 64) ((LAS unsigned*)(F.lds + LDSCTL_OFF))[u] = 0u;
    __syncthreads();
    XcdBarrier bar = xcd_barrier_post((unsigned*)(F.ctl + CW_BAR), F.MISC + 8);
    const int lo = args.ph_lo, hi = args.ph_hi;
#ifndef PH_MASK
#define PH_MASK 0x3ff
#endif
#define IN(k) ((((PH_MASK) >> (k)) & 1) && lo <= (k) && (k) < hi)
#define BOTH(k) (IN(k) && IN((k) + 1))
    bf16* const W1UZ = (bf16*)(ws + WS_W1UZ); bf16* const W1V = (bf16*)(ws + WS_W1V); bf16* const W2 = (bf16*)(ws + WS_W2); bf16* const W3 = (bf16*)(ws + WS_W3);
    bf16* const W4 = (bf16*)(ws + WS_W4); bf16* const W5 = (bf16*)(ws + WS_W5); bf16* const Hb = (bf16*)(ws + WS_H); bf16* const B0 = (bf16*)(ws + WS_B0);
    bf16* const B1 = (bf16*)(ws + WS_B1); bf16* const B2 = (bf16*)(ws + WS_B2); bf16* const Mb = (bf16*)(ws + WS_M); float* const ST = (float*)(ws + WS_ST);

    unsigned long long pc_t0 = 0, pc_r0 = 0, pc_mhz = 0;
#define PCLK_BEGIN(k) do { if (PROBE_CLK == (k) + 1 || PROBE_DUR == (k) + 1) { pc_t0 = __builtin_amdgcn_s_memtime(); pc_r0 = __builtin_amdgcn_s_memrealtime(); } } while (0)
#define PCLK_END(k) do { if (PROBE_CLK == (k) + 1) { const unsigned long long t1 = __builtin_amdgcn_s_memtime(), r1 = __builtin_amdgcn_s_memrealtime(); pc_mhz = (t1 - pc_t0) * 100ull / (r1 - pc_r0 + 1ull); } \
        if (PROBE_DUR == (k) + 1) { pc_mhz = (__builtin_amdgcn_s_memrealtime() - pc_r0) / 100ull; } } while (0)
    PCLK_BEGIN(0);
    if (IN(0)) { p0_prologue(args, F); if ((REPEAT_MASK >> 0) & 1) { __syncthreads(); p0_prologue(args, F); } if (BOTH(0)) xcd_barrier(bar); }

    PCLK_END(0);
    PCLK_BEGIN(1);
    if (IN(1)) {
#pragma unroll
        for (int rep = 0; rep < 1 + ((REPEAT_MASK >> 1) & 1); ++rep) { if (rep) __syncthreads();
        if (DELAY_P1_US > 0 && rep == 0) { const unsigned long long r0 = __builtin_amdgcn_s_memrealtime(), ticks = (unsigned long long)(blockIdx.x >> 3) * (DELAY_P1_US * 100ull) / 32ull; while (__builtin_amdgcn_s_memrealtime() - r0 < ticks) __builtin_amdgcn_s_sleep(8); __syncthreads(); }
        if (STAGGER) { conv_rounds(args, F, CSET_B, CNT_B, 0, conv_npre(F, CNT_B)); asm volatile("s_waitcnt vmcnt(0)" ::: "memory"); __syncthreads(); }
        { pg8::Gemm g{Hb, W1UZ, DM, DM, DM, 0, 0, 0, 0}; pg8::StaticOrder S; S.init(MTOK, 2 * EI, F.G, (int)blockIdx.x);
          pg8::EpiUZ E{B0, EI};
          pg8::gemm_phase<pg8::EpiUZ, pg8::StaticOrder, GALIGN, GSP2, (PROBE_EPI != 0)>(F.lds + RING_OFF, g, S, E); }
        __syncthreads();
        { pg8::Gemm g{W1V, Hb, DM, DM, DM, 0, 0, 0, 0}; pg8::StaticOrder S; S.init(EI, MTOK, F.G, (int)blockIdx.x);
          pg8::EpiGvT E{B1, MTOK, ST, MTOK};
          pg8::gemm_phase<pg8::EpiGvT, pg8::StaticOrder, GALIGN, GSP2>(F.lds + RING_OFF, g, S, E); }
        if (STAGGER) conv_rounds(args, F, CSET_B, CNT_B, conv_npre(F, CNT_B), conv_nrounds(F, CNT_B));
        }
        if (BOTH(1)) xcd_barrier(bar);
    }

    PCLK_END(1);
    PCLK_BEGIN(2);
    if (IN(2)) { sgu_phase(args, F); if ((REPEAT_MASK >> 2) & 1) { __syncthreads(); sgu_phase(args, F); } if (BOTH(2)) xcd_barrier(bar); }

    PCLK_END(2);
    PCLK_BEGIN(3);
    if (IN(3)) {
#pragma unroll
        for (int rep = 0; rep < 1 + ((REPEAT_MASK >> 3) & 1); ++rep) { if (rep) __syncthreads();
        pg8::Gemm g{B2, W2, EI, EI, EI, 0, 0, 0, 0}; pg8::StaticOrder S; S.init(MTOK, DM, F.G, (int)blockIdx.x);
        pg8::EpiPlain E{Mb, DM};
        pg8::gemm_phase<pg8::EpiPlain, pg8::StaticOrder, GALIGN, GSP2>(F.lds + RING_OFF, g, S, E);
        }
        if (BOTH(3)) xcd_barrier(bar);
    }

    PCLK_END(3);
    PCLK_BEGIN(4);
    if (IN(4)) { norm_phase<false>(Mb, args.in[IN_X], args.out, args.in[IN_POST], args.in[IN_PRE] + DM, Hb, X1BF16 ? (bf16*)(ws + WS_X1B) : nullptr, F); if ((REPEAT_MASK >> 4) & 1) norm_phase<false>(Mb, args.in[IN_X], args.out, args.in[IN_POST], args.in[IN_PRE] + DM, Hb, X1BF16 ? (bf16*)(ws + WS_X1B) : nullptr, F); if (BOTH(4)) xcd_barrier(bar); }

#if WCOMB
    PCLK_END(4);
    PCLK_BEGIN(5);
    if (IN(5)) {
#pragma unroll
        for (int rep = 0; rep < 1 + ((REPEAT_MASK >> 5) & 1); ++rep) { if (rep) __syncthreads();
#ifndef NO_POOLH
        poolh_phase(args, F);
#endif
        __syncthreads();
        { pg8::Gemm g{Hb, W3, DM, DM, DM, 0, 0, 0, 0}; pg8::StaticOrder S; S.init(MTOK, EI, F.G, (int)blockIdx.x);
          pg8::EpiPZ E{nullptr, B0, EI, 0};
          pg8::gemm_phase<pg8::EpiPZ, pg8::StaticOrder, GALIGN, GSP2>(F.lds + RING_OFF, g, S, E); }
        __syncthreads();
        { pg8::Gemm g{W4, (const bf16*)(ws + WS_W3P), GWID, EI, GWID, 0, 0, GWID / 256, (size_t)GWID * 2}; pg8::StaticOrder S; S.init(EI, DM, F.G, (int)blockIdx.x);
          pg8::EpiPlain E{(bf16*)(ws + WS_WC), DM};
          pg8::gemm_phase<pg8::EpiPlain, pg8::StaticOrder, GALIGN, GSP2>(F.lds + RING_OFF, g, S, E); }
        }
        if (BOTH(5)) xcd_barrier(bar);
    }
    PCLK_END(5);
    PCLK_BEGIN(6);
    PCLK_END(6);
    PCLK_BEGIN(7);
    if (IN(7)) {
#pragma unroll
        for (int rep = 0; rep < 1 + ((REPEAT_MASK >> 7) & 1); ++rep) { if (rep) __syncthreads();
        pg8::Gemm g{(const bf16*)(ws + WS_PH), (const bf16*)(ws + WS_WC), DM, DM, DM, GWID / 256, (size_t)MTOK * DM * 2, 0, 0}; pg8::StaticOrder S; S.init(MTOK, EI, F.G, (int)blockIdx.x);
        pg8::EpiMix E{B0, (bf16*)(ws + WS_Y1), EI, args.in[IN_BBGRP], args.in[IN_BSCALE]};
        pg8::gemm_phase<pg8::EpiMix, pg8::StaticOrder, GALIGN, GSP2>(F.lds + RING_OFF, g, S, E);
        }
        if (BOTH(7)) xcd_barrier(bar);
    }
#else
    PCLK_END(4);
    PCLK_BEGIN(5);
    if (IN(5)) {
#pragma unroll
        for (int rep = 0; rep < 1 + ((REPEAT_MASK >> 5) & 1); ++rep) { if (rep) __syncthreads();
        if (STAGGER) { conv_rounds(args, F, CSET_C, CNT_C, 0, conv_npre(F, CNT_C)); asm volatile("s_waitcnt vmcnt(0)" ::: "memory"); __syncthreads(); }
        pg8::Gemm g{Hb, W3, DM, DM, DM, 0, 0, 0, 0}; pg8::StaticOrder S; S.init(MTOK, 2 * EI, F.G, (int)blockIdx.x);
        pg8::EpiPZ E{B1, B0, EI, EI / 256};
        pg8::gemm_phase<pg8::EpiPZ, pg8::StaticOrder, GALIGN, GSP2>(F.lds + RING_OFF, g, S, E);
        if (STAGGER) conv_rounds(args, F, CSET_C, CNT_C, conv_npre(F, CNT_C), conv_nrounds(F, CNT_C));
        }
        if (BOTH(5)) xcd_barrier(bar);
    }

    PCLK_END(5);
    PCLK_BEGIN(6);
    if (IN(6)) { pool_phase(args, F); if ((REPEAT_MASK >> 6) & 1) pool_phase(args, F); if (BOTH(6)) xcd_barrier(bar); }

    PCLK_END(6);
    PCLK_BEGIN(7);
    if (IN(7)) {
#pragma unroll
        for (int rep = 0; rep < 1 + ((REPEAT_MASK >> 7) & 1); ++rep) { if (rep) __syncthreads();
        pg8::Gemm g{B2, W4, EI, GWID, GWID, GWID / 256, (size_t)GWID * 2, 0, 0}; pg8::StaticOrder S; S.init(MTOK, EI, F.G, (int)blockIdx.x);
        pg8::EpiMix E{B0, B1, EI, args.in[IN_BBGRP], args.in[IN_BSCALE]};
        pg8::gemm_phase<pg8::EpiMix, pg8::StaticOrder, GALIGN, GSP2>(F.lds + RING_OFF, g, S, E);
        }
        if (BOTH(7)) xcd_barrier(bar);
    }

#endif

    PCLK_END(7);
    PCLK_BEGIN(8);
    if (IN(8)) {
#pragma unroll
        for (int rep = 0; rep < 1 + ((REPEAT_MASK >> 8) & 1); ++rep) { if (rep) __syncthreads();
        pg8::Gemm g{WCOMB ? (const bf16*)(ws + WS_Y1) : (const bf16*)B1, W5, EI, EI, EI, 0, 0, 0, 0}; pg8::StaticOrder S; S.init(MTOK, DM, F.G, (int)blockIdx.x);
        pg8::EpiPlain E{Mb, DM};
        pg8::gemm_phase<pg8::EpiPlain, pg8::StaticOrder, GALIGN, GSP2>(F.lds + RING_OFF, g, S, E);
        }
        if (BOTH(8)) xcd_barrier(bar);
    }

    PCLK_END(8);
    PCLK_BEGIN(9);
    if (IN(9)) {
        norm_phase<true>(Mb, args.out, args.out, args.in[IN_POST] + DM, nullptr, nullptr, X1BF16 ? (bf16*)(ws + WS_X1B) : nullptr, F);
        if (__hip_atomic_load(F.ctl + CW_BAR + XB_TMO, RLX_AGENT) != 0u) {
            const int gw = F.vcu * NWAVES + F.wave, NGW = F.G * NWAVES; const float q = __builtin_nanf("");
            for (int m = gw; m < MTOK; m += NGW) { GAS f32x4* o = (GAS f32x4*)(args.out + (size_t)m * DM) + F.lane;
#pragma unroll
                for (int j = 0; j < 16; ++j) o[64 * j] = (f32x4){q, q, q, q}; } }
    }
    PCLK_END(9);
    if (PROBE_EPI != 0 && blockIdx.x == 0 && F.tid == 0) { const LAS unsigned long long* st = (const LAS unsigned long long*)(F.lds + RING_OFF + pg8::STAGE_BYTES + 1024);
        const unsigned long long v = PROBE_EPI == 1 ? (st[1] - st[0]) / 10ull : PROBE_EPI == 2 ? (st[2] - st[1]) / 10ull : PROBE_EPI == 3 ? (st[3] - st[2]) / 64ull : (st[4] - st[1]) / 100ull;
        const unsigned long long r0 = __builtin_amdgcn_s_memrealtime(), ticks = (v > 6000ull ? 6000ull : v) * 100ull; while (__builtin_amdgcn_s_memrealtime() - r0 < ticks) __builtin_amdgcn_s_sleep(32); }
    if ((PROBE_CLK != 0 || PROBE_DUR != 0) && blockIdx.x == 0 && F.tid == 0) { const unsigned long long r0 = __builtin_amdgcn_s_memrealtime(); const unsigned long long ticks = (pc_mhz > 5000ull ? 5000ull : pc_mhz) * 100ull;
        while (__builtin_amdgcn_s_memrealtime() - r0 < ticks) __builtin_amdgcn_s_sleep(32); }
#undef IN
#undef BOTH
}

#if NAIVE_MASK != 0
#if WCOMB && (NAIVE_MASK & 0xE0)
#error "the reference implementations of phases 5-7 follow the literal order: build them with WCOMB 0"
#endif
__device__ __forceinline__ bf16 nv_f2bf(float f) { unsigned u = __float_as_uint(f); u += 0x7fffu + ((u >> 16) & 1u); return (bf16)(u >> 16); }
__device__ __forceinline__ float nv_bf2f(bf16 b) { return __uint_as_float(((unsigned)b) << 16); }
__device__ __forceinline__ float nv_gelu(float v) { return 0.5f * v * (1.0f + erff(v * 0.70710678118654752f)); }
__device__ __forceinline__ float nv_silu(float v) { return v / (1.0f + expf(-v)); }
__global__ void nv_transpose(const float* W, int ldw, int K, int Nd, bf16* WT, int mode) {
    const size_t total = (size_t)Nd * K;
    for (size_t i = (size_t)blockIdx.x * blockDim.x + threadIdx.x; i < total; i += (size_t)gridDim.x * blockDim.x) {
        const int r = (int)(i / K), k = (int)(i % K); int c = r;
        if (mode == 1) { const int t = r >> 8, j = r & 255; c = j < 128 ? 128 * t + j : 2 * EI + 128 * t + (j - 128); }
        if (mode == 2) c = EI + r;
        WT[i] = nv_f2bf(W[(size_t)k * ldw + c]); }
}
__global__ void nv_rms_h(const float* x, const float* g, bf16* H) {
    const int m = blockIdx.x, lane = threadIdx.x; float s = 0.f;
    for (int c = lane; c < DM; c += 64) { const float v = x[(size_t)m * DM + c]; s += v * v; }
    for (int o = 1; o < 64; o <<= 1) s += __shfl_xor(s, o);
    const float rstd = 1.f / sqrtf(s / DM + EPS);
    for (int c = lane; c < DM; c += 64) H[(size_t)m * DM + c] = nv_f2bf(x[(size_t)m * DM + c] * rstd * g[c]);
}
struct NvUZ { bf16* U; bf16* Zt; __device__ void operator()(int r, int c, float v) const { const int t = c >> 8, j = c & 255;
    if (j < 128) U[(size_t)r * EI + 128 * t + j] = nv_f2bf(nv_gelu(v)); else Zt[(size_t)r * EI + 128 * t + (j - 128)] = nv_f2bf(nv_silu(v)); } };
struct NvGvT { bf16* O; __device__ void operator()(int r, int c, float v) const { O[(size_t)c * MTOK + r] = nv_f2bf(nv_gelu(v)); } };
struct NvPlain { bf16* O; int ldc; int pad; __device__ void operator()(int r, int c, float v) const { O[(size_t)r * ldc + c] = nv_f2bf(v); } };
struct NvPZ { bf16* P; bf16* SZ; __device__ void operator()(int r, int c, float v) const { if (c < EI) P[(size_t)r * EI + c] = nv_f2bf(v); else SZ[(size_t)r * EI + c - EI] = nv_f2bf(nv_silu(v)); } };
struct NvMix { const bf16* SZ; bf16* Y; const float* bgrp; const float* scale; int g; int pad; __device__ void operator()(int r, int c, float v) const { const int ch = g * GWID + c;
    Y[(size_t)r * EI + ch] = nv_f2bf((v + bgrp[ch]) * scale[ch] * nv_bf2f(SZ[(size_t)r * EI + ch])); } };
template <class Epi> __global__ void __launch_bounds__(256) nv_gemm(const bf16* A, int lda, const bf16* Bt, int ldb, int K, Epi epi) {
    __shared__ float As[16][65], Bs[16][65];
    const int tid = threadIdx.x, tx = tid & 15, ty = tid >> 4, row0 = blockIdx.y * 64, col0 = blockIdx.x * 64;
    float acc[4][4];
#pragma unroll
    for (int i = 0; i < 4; ++i)
#pragma unroll
        for (int j = 0; j < 4; ++j) acc[i][j] = 0.f;
    const int lr = tid >> 2, lk = (tid & 3) * 4;
    for (int k0 = 0; k0 < K; k0 += 16) {
#pragma unroll
        for (int i = 0; i < 4; ++i) { As[lk + i][lr] = nv_bf2f(A[(size_t)(row0 + lr) * lda + k0 + lk + i]); Bs[lk + i][lr] = nv_bf2f(Bt[(size_t)(col0 + lr) * ldb + k0 + lk + i]); }
        __syncthreads();
#pragma unroll
        for (int k = 0; k < 16; ++k) { float av[4], bv[4];
#pragma unroll
            for (int i = 0; i < 4; ++i) { av[i] = As[k][ty * 4 + i]; bv[i] = Bs[k][tx * 4 + i]; }
#pragma unroll
            for (int i = 0; i < 4; ++i)
#pragma unroll
                for (int j = 0; j < 4; ++j) acc[i][j] += av[i] * bv[j]; }
        __syncthreads();
    }
#pragma unroll
    for (int i = 0; i < 4; ++i)
#pragma unroll
        for (int j = 0; j < 4; ++j) epi(row0 + ty * 4 + i, col0 + tx * 4 + j, acc[i][j]);
}
__global__ void nv_mul(bf16* U, const bf16* Zt, size_t n) { for (size_t i = (size_t)blockIdx.x * blockDim.x + threadIdx.x; i < n; i += (size_t)gridDim.x * blockDim.x) U[i] = nv_f2bf(nv_bf2f(U[i]) * nv_bf2f(Zt[i])); }
__global__ void nv_stats(const bf16* GVT, float* ST) {
    const int tok = blockIdx.x * blockDim.x + threadIdx.x; if (tok >= MTOK) return; float s = 0.f, ss = 0.f;
    for (int ch = 0; ch < EI; ++ch) { const float v = nv_bf2f(GVT[(size_t)ch * MTOK + tok]); s += v; ss += v * v; }
    ST[(size_t)tok * 2] = s; ST[(size_t)tok * 2 + 1] = ss;
    for (int p = 1; p < NST; ++p) { ST[((size_t)p * MTOK + tok) * 2] = 0.f; ST[((size_t)p * MTOK + tok) * 2 + 1] = 0.f; }
}
__global__ void nv_murs(const float* ST, float* MR) {
    const int tok = blockIdx.x * blockDim.x + threadIdx.x; if (tok >= MTOK) return; float s = 0.f, ss = 0.f;
    for (int p = 0; p < NST; ++p) { s += ST[((size_t)p * MTOK + tok) * 2]; ss += ST[((size_t)p * MTOK + tok) * 2 + 1]; }
    const float mean = s / EI; float var = ss / EI - mean * mean; var = var > 0.f ? var : 0.f; MR[tok * 2] = mean; MR[tok * 2 + 1] = 1.f / sqrtf(var + EPS);
}
__global__ void nv_sgu(const bf16* GVT, const float* MR, const bf16* UZ, const float* lng, const float* lnb, const float* wsp, const float* bsv, bf16* Y) {
    const size_t total = (size_t)MTOK * EI;
    for (size_t i = (size_t)blockIdx.x * blockDim.x + threadIdx.x; i < total; i += (size_t)gridDim.x * blockDim.x) {
        const int ch = (int)(i / MTOK), tok = (int)(i % MTOK), h = ch / HDIM, t = tok & (CHUNK - 1), R0 = tok - t;
        float sv = 0.f;
        for (int s = 0; s <= t; ++s) { const float vn = (nv_bf2f(GVT[(size_t)ch * MTOK + R0 + s]) - MR[(R0 + s) * 2]) * MR[(R0 + s) * 2 + 1] * lng[ch] + lnb[ch];
            sv += wsp[((size_t)h * CHUNK + t) * CHUNK + s] * vn; }
        sv += bsv[h * CHUNK + t];
        Y[(size_t)tok * EI + ch] = nv_f2bf(nv_bf2f(UZ[(size_t)tok * EI + ch]) * sv); }
}
__global__ void nv_pool(const bf16* P, bf16* O) {
    const size_t total = (size_t)MTOK * EI;
    for (size_t i = (size_t)blockIdx.x * blockDim.x + threadIdx.x; i < total; i += (size_t)gridDim.x * blockDim.x) {
        const int tok = (int)(i / EI), ch = (int)(i % EI), g = ch / GWID, W = 2 << g, tseq = tok & (SEQ - 1), cnt = (tseq + 1 < W) ? tseq + 1 : W;
        float s = 0.f; for (int j = 0; j < cnt; ++j) s += nv_bf2f(P[(size_t)(tok - j) * EI + ch]);
        O[i] = nv_f2bf(s / (float)cnt - nv_bf2f(P[i])); }
}
static void launch_naive_phase(int k, const Args& a, hipStream_t stream) {
    unsigned char* ws = a.ws;
    bf16* W1UZ = (bf16*)(ws + WS_W1UZ); bf16* W1V = (bf16*)(ws + WS_W1V); bf16* W2 = (bf16*)(ws + WS_W2); bf16* W3 = (bf16*)(ws + WS_W3); bf16* W4 = (bf16*)(ws + WS_W4); bf16* W5 = (bf16*)(ws + WS_W5);
    bf16* Hb = (bf16*)(ws + WS_H); bf16* B0 = (bf16*)(ws + WS_B0); bf16* B1 = (bf16*)(ws + WS_B1); bf16* B2 = (bf16*)(ws + WS_B2); bf16* Mb = (bf16*)(ws + WS_M); float* ST = (float*)(ws + WS_ST); float* MR = (float*)(ws + WS_DBG);
    const dim3 blk(256);
    switch (k) {
    case 0:
        hipLaunchKernelGGL(nv_transpose, dim3(8192), blk, 0, stream, a.in[IN_AWIN], 3 * EI, DM, 2 * EI, W1UZ, 1);
        hipLaunchKernelGGL(nv_transpose, dim3(8192), blk, 0, stream, a.in[IN_AWIN], 3 * EI, DM, EI, W1V, 2);
        hipLaunchKernelGGL(nv_transpose, dim3(8192), blk, 0, stream, a.in[IN_AWOUT], DM, EI, DM, W2, 0);
        hipLaunchKernelGGL(nv_transpose, dim3(8192), blk, 0, stream, a.in[IN_BWIN], 2 * EI, DM, 2 * EI, W3, 0);
        for (int g = 0; g < NGRP; ++g) hipLaunchKernelGGL(nv_transpose, dim3(4096), blk, 0, stream, a.in[IN_BWGRP] + (size_t)g * GWID * GWID, GWID, GWID, GWID, W4 + (size_t)g * GWID * GWID, 0);
        hipLaunchKernelGGL(nv_transpose, dim3(8192), blk, 0, stream, a.in[IN_BWOUT], DM, EI, DM, W5, 0);
        hipLaunchKernelGGL(nv_rms_h, dim3(MTOK), dim3(64), 0, stream, a.in[IN_X], a.in[IN_PRE], Hb);
        break;
    case 1:
        hipLaunchKernelGGL(nv_gemm<NvUZ>, dim3(2 * EI / 64, MTOK / 64), blk, 0, stream, (const bf16*)Hb, DM, (const bf16*)W1UZ, DM, DM, NvUZ{B0, B2});
        hipLaunchKernelGGL(nv_mul, dim3(8192), blk, 0, stream, B0, (const bf16*)B2, (size_t)MTOK * EI);
        hipLaunchKernelGGL(nv_gemm<NvGvT>, dim3(EI / 64, MTOK / 64), blk, 0, stream, (const bf16*)Hb, DM, (const bf16*)W1V, DM, DM, NvGvT{B1});
        hipLaunchKernelGGL(nv_stats, dim3(MTOK / 256), blk, 0, stream, (const bf16*)B1, ST);
        break;
    case 2:
        hipLaunchKernelGGL(nv_murs, dim3(MTOK / 256), blk, 0, stream, (const float*)ST, MR);
        hipLaunchKernelGGL(nv_sgu, dim3(16384), blk, 0, stream, (const bf16*)B1, (const float*)MR, (const bf16*)B0, a.in[IN_ALNG], a.in[IN_ALNB], a.in[IN_AWS], a.in[IN_ABS], B2);
        break;
    case 3: hipLaunchKernelGGL(nv_gemm<NvPlain>, dim3(DM / 64, MTOK / 64), blk, 0, stream, (const bf16*)B2, EI, (const bf16*)W2, EI, EI, NvPlain{Mb, DM, 0}); break;
    case 5: hipLaunchKernelGGL(nv_gemm<NvPZ>, dim3(2 * EI / 64, MTOK / 64), blk, 0, stream, (const bf16*)Hb, DM, (const bf16*)W3, DM, DM, NvPZ{B1, B0}); break;
    case 6: hipLaunchKernelGGL(nv_pool, dim3(16384), blk, 0, stream, (const bf16*)B1, B2); break;
    case 7:
        for (int g = 0; g < NGRP; ++g) hipLaunchKernelGGL(nv_gemm<NvMix>, dim3(GWID / 64, MTOK / 64), blk, 0, stream, (const bf16*)B2 + (size_t)g * GWID, EI, (const bf16*)W4 + (size_t)g * GWID * GWID, GWID, GWID,
                                                          NvMix{(const bf16*)B0, B1, a.in[IN_BBGRP], a.in[IN_BSCALE], g, 0});
        break;
    case 8: hipLaunchKernelGGL(nv_gemm<NvPlain>, dim3(DM / 64, MTOK / 64), blk, 0, stream, (const bf16*)B1, EI, (const bf16*)W5, EI, EI, NvPlain{Mb, DM, 0}); break;
    default: break;
    }
}
#endif

extern "C" void kernel_launch(void* const* d_in, const int* in_sizes, int n_in, void* d_out, int out_size, void* d_ws, size_t ws_size, hipStream_t stream) {
    static int grid = 0;
    if (grid == 0) {
        if (n_in != N_IN || in_sizes[0] != MTOK * DM || out_size != MTOK * DM || ws_size < WS_END) {
            fprintf(stderr, "kernel_launch: built for %d inputs, x and out of %d floats, >= %zu bytes of workspace; got n_in %d, in0 %d, out %d, ws %zu; nothing launched\n", (int)N_IN, MTOK * DM, (size_t)WS_END, n_in, n_in > 0 ? in_sizes[0] : -1, out_size, ws_size); grid = -1; return; }
        int dev = 0, cus = 0, per_cu = 0;
        if (hipGetDevice(&dev) != hipSuccess || hipDeviceGetAttribute(&cus, hipDeviceAttributeMultiprocessorCount, dev) != hipSuccess) { fprintf(stderr, "kernel_launch: hipGetDevice / hipDeviceGetAttribute failed; nothing launched\n"); grid = -1; return; }
        if (hipFuncSetAttribute((const void*)skel_fwd, hipFuncAttributeMaxDynamicSharedMemorySize, LDS_BYTES) != hipSuccess) { fprintf(stderr, "kernel_launch: hipFuncSetAttribute failed (%d bytes of dynamic LDS); nothing launched\n", LDS_BYTES); grid = -1; return; }
        if (hipOccupancyMaxActiveBlocksPerMultiprocessor(&per_cu, (const void*)skel_fwd, NWAVES * 64, LDS_BYTES) != hipSuccess || per_cu < 1)
            fprintf(stderr, "kernel_launch: note: the occupancy query reports %d workgroups per CU; launching one per CU\n", per_cu);
        (void)hipGetLastError();
        grid = cus;
    }
    if (grid < 0) return;
    if (hipMemsetAsync((char*)d_ws + WS_CTL, 0, CTL_ZERO_BYTES, stream) != hipSuccess) { fprintf(stderr, "kernel_launch: hipMemsetAsync of the control words failed; nothing launched\n"); return; }
    Args a{};
    for (int i = 0; i < N_IN; ++i) a.in[i] = (const float*)d_in[i];
    a.out = (float*)d_out; a.ws = (unsigned char*)d_ws;
#if NAIVE_MASK == 0
    a.ph_lo = 0; a.ph_hi = NPH;
    hipLaunchKernelGGL(skel_fwd, dim3(grid), dim3(NWAVES * 64), LDS_BYTES, stream, a);
    { const hipError_t le = hipPeekAtLastError(); if (le != hipSuccess) fprintf(stderr, "kernel_launch: launch failed: %s (grid %d x %d threads, %d B LDS)\n", hipGetErrorName(le), grid, NWAVES * 64, LDS_BYTES); }
#else
    for (int k = 0; k < NPH; ++k) {
        if ((NAIVE_MASK >> k) & 1 && k != 4 && k != 9) { launch_naive_phase(k, a, stream); continue; }
        a.ph_lo = k; a.ph_hi = k + 1;
        hipLaunchKernelGGL(skel_fwd, dim3(grid), dim3(NWAVES * 64), LDS_BYTES, stream, a);
        const hipError_t le = hipPeekAtLastError(); if (le != hipSuccess) { fprintf(stderr, "kernel_launch: launch of phase %d failed: %s\n", k, hipGetErrorName(le)); break; }
    }
#endif
}
```
